# Optimizing an MI355X kernel written in HIP

```python
import math
import jax, jax.numpy as jnp
from jax import lax
import numpy as np

D_MODEL = 1024
BATCH = 8
SEQ = 4096
DEPTH = 4

BLOCK = 128
EPS = 1e-6
NEG = -1e30

MLA_HEADS = 8
MLA_Q_RANK = 256
MLA_KV_RANK = 128
MLA_NOPE = 64
MLA_ROPE = 32
MLA_V = 64
MLA_WIDTH = MLA_HEADS * MLA_V
ROPE_THETA = 10000.0

SWA_HEADS = 8
SWA_KV_HEADS = 2
SWA_GROUP = SWA_HEADS // SWA_KV_HEADS
SWA_HEAD_DIM = 64
SWA_WINDOW = 128
SWA_WIDTH = SWA_HEADS * SWA_HEAD_DIM
SWA_KV_WIDTH = SWA_KV_HEADS * SWA_HEAD_DIM

DIFF_HEADS = 4
DIFF_HEAD_DIM = 64
DIFF_WIDTH = DIFF_HEADS * 2 * DIFF_HEAD_DIM

REL_BUCKETS = 32
REL_MAX_DIST = 128
REL_HEADS = SWA_HEADS + DIFF_HEADS

N_BRANCH = 3

IN_SPLITS = (MLA_Q_RANK, MLA_KV_RANK, MLA_ROPE, MLA_WIDTH,
             SWA_WIDTH, SWA_KV_WIDTH, SWA_KV_WIDTH, SWA_WIDTH,
             DIFF_WIDTH, DIFF_WIDTH, DIFF_WIDTH, DIFF_WIDTH,
             N_BRANCH * D_MODEL)
IN_COLS = sum(IN_SPLITS)

kernel_name = "hybrid_mla_swa_diff_encoder"


def rms_norm(x, g):
    xf = x.astype(jnp.float32)
    y = xf * lax.rsqrt(jnp.mean(xf * xf, axis=-1, keepdims=True) + EPS)
    return (y * g.astype(jnp.float32)).astype(x.dtype)


def split_cols(t, sizes):
    out, o = [], 0
    for n in sizes:
        out.append(t[..., o:o + n])
        o += n
    return out


def rope(x, cos, sin):
    half = x.shape[-1] // 2
    x1, x2 = x[..., :half], x[..., half:]
    cos = cos.astype(x.dtype)
    sin = sin.astype(x.dtype)
    return jnp.concatenate([x1 * cos - x2 * sin, x2 * cos + x1 * sin], axis=-1)


def t5_bucket(rel):
    nb = REL_BUCKETS // 2
    max_exact = nb // 2
    base = jnp.where(rel > 0, nb, 0)
    n = jnp.abs(rel)
    nf = jnp.maximum(n, 1).astype(jnp.float32)
    large = max_exact + (jnp.log(nf / max_exact) / math.log(REL_MAX_DIST / max_exact)
                         * (nb - max_exact)).astype(jnp.int32)
    large = jnp.minimum(large, nb - 1)
    return base + jnp.where(n < max_exact, n, large)


def mla_branch(c_q, c_kv, k_r, g_q, w_uq, g_kv, w_ukv, cos, sin):
    B, S, _ = c_q.shape
    q = (rms_norm(c_q, g_q) @ w_uq).reshape(B, S, MLA_HEADS, MLA_NOPE + MLA_ROPE)
    q = jnp.concatenate([q[..., :MLA_NOPE],
                         rope(q[..., MLA_NOPE:], cos[None, :, None, :], sin[None, :, None, :])], axis=-1)
    kv = (rms_norm(c_kv, g_kv) @ w_ukv).reshape(B, S, MLA_HEADS, MLA_NOPE + MLA_V)
    k_pe = rope(k_r, cos[None], sin[None])
    k = jnp.concatenate([kv[..., :MLA_NOPE],
                         jnp.broadcast_to(k_pe[:, :, None, :], (B, S, MLA_HEADS, MLA_ROPE))], axis=-1)
    v = kv[..., MLA_NOPE:]
    scale = (MLA_NOPE + MLA_ROPE) ** -0.5

    def attend(qb):
        s = jnp.einsum('bqhd,bkhd->bhqk', qb, k).astype(jnp.float32) * scale
        p = jax.nn.softmax(s, axis=-1).astype(v.dtype)
        return jnp.einsum('bhqk,bkhd->bqhd', p, v)

    nq = S // BLOCK
    qb = q.reshape(B, nq, BLOCK, MLA_HEADS, MLA_NOPE + MLA_ROPE).swapaxes(0, 1)
    o = lax.map(attend, qb)
    return o.swapaxes(0, 1).reshape(B, S, MLA_WIDTH)


def swa_branch(q, k, v, sink, bias_band):
    B, S, _ = q.shape
    nb = S // BLOCK
    q = q.reshape(B, nb, BLOCK, SWA_KV_HEADS, SWA_GROUP, SWA_HEAD_DIM)

    def band(t):
        t = t.reshape(B, S, SWA_KV_HEADS, SWA_HEAD_DIM)
        tp = jnp.pad(t, ((0, 0), (BLOCK, BLOCK), (0, 0), (0, 0)))
        tp = tp.reshape(B, nb + 2, BLOCK, SWA_KV_HEADS, SWA_HEAD_DIM)
        return jnp.concatenate([tp[:, :-2], tp[:, 1:-1], tp[:, 2:]], axis=2)

    kb, vb = band(k), band(v)
    s = jnp.einsum('bnqgrd,bnkgd->bngrqk', q, kb).astype(jnp.float32) * SWA_HEAD_DIM ** -0.5
    s = s + bias_band.reshape(SWA_KV_HEADS, SWA_GROUP, BLOCK, 3 * BLOCK)[None, None]
    t = jnp.arange(BLOCK)
    j = jnp.arange(3 * BLOCK)
    blk = jnp.arange(nb)
    rel = j[None, :] - BLOCK - t[:, None]
    kpos = blk[:, None] * BLOCK - BLOCK + j[None, :]
    valid = (jnp.abs(rel) <= SWA_WINDOW)[None] & ((kpos >= 0) & (kpos < S))[:, None, :]
    s = jnp.where(valid[None, :, None, None], s, NEG)
    sink_l = sink.astype(jnp.float32).reshape(SWA_KV_HEADS, SWA_GROUP)[None, None, :, :, None, None]
    m = jnp.maximum(jnp.max(s, axis=-1, keepdims=True), sink_l)
    p = jnp.exp(s - m)
    p = p / (jnp.sum(p, axis=-1, keepdims=True) + jnp.exp(sink_l - m))
    o = jnp.einsum('bngrqk,bnkgd->bnqgrd', p.astype(v.dtype), vb)
    return o.reshape(B, S, SWA_WIDTH)


def diff_branch(q, k, v, lam_q1, lam_k1, lam_q2, lam_k2, g_sub, rel_bias, lam_init):
    B, S, _ = q.shape
    H, d = DIFF_HEADS, DIFF_HEAD_DIM
    q = q.reshape(B, S, H, 2, d)
    k = k.reshape(B, S, H, 2, d)
    v = v.reshape(B, S, H, 2 * d)
    f32 = jnp.float32
    lam = (jnp.exp(jnp.sum(lam_q1.astype(f32) * lam_k1.astype(f32)))
           - jnp.exp(jnp.sum(lam_q2.astype(f32) * lam_k2.astype(f32))) + lam_init)
    table = rel_bias[:, SWA_HEADS:].astype(f32)
    kpos = jnp.arange(S)

    def attend(args):
        i, qb = args
        qpos = i * BLOCK + jnp.arange(BLOCK)
        bias = table[t5_bucket(kpos[None, :] - qpos[:, None])].transpose(2, 0, 1)
        s = jnp.einsum('bqhcd,bkhcd->bchqk', qb, k).astype(f32) * d ** -0.5 + bias[None, None]
        p = jax.nn.softmax(s, axis=-1)
        a = p[:, 0] - lam * p[:, 1]
        return jnp.einsum('bhqk,bkhe->bqhe', a.astype(v.dtype), v)

    nq = S // BLOCK
    qb = q.reshape(B, nq, BLOCK, H, 2, d).swapaxes(0, 1)
    o = lax.map(attend, (jnp.arange(nq), qb))
    o = o.swapaxes(0, 1).reshape(B, S, H, 2 * d)
    o = rms_norm(o, g_sub) * (1.0 - lam_init)
    return o.reshape(B, S, DIFF_WIDTH)


def setup_inputs(seed: int = 0) -> dict:
    key = jax.random.key(seed)
    ks = jax.random.split(key, 24)
    D, L = D_MODEL, DEPTH
    nrm = jax.random.normal
    f32 = jnp.float32
    return {
        "x": nrm(ks[0], (BATCH, SEQ, D), f32),
        "c": nrm(ks[1], (BATCH, D), f32),
        "w_ada": nrm(ks[2], (L, D, 3 * D), f32) * (0.5 * D ** -0.5),
        "b_ada": nrm(ks[3], (L, 3 * D), f32) * 0.01,
        "g_pre": 1.0 + 0.1 * nrm(ks[4], (L, D), f32),
        "g_post": 1.0 + 0.1 * nrm(ks[5], (L, D), f32),
        "w_in": nrm(ks[6], (L, D, IN_COLS), f32) * D ** -0.5,
        "g_q": 1.0 + 0.1 * nrm(ks[7], (L, MLA_Q_RANK), f32),
        "w_uq": nrm(ks[8], (L, MLA_Q_RANK, MLA_HEADS * (MLA_NOPE + MLA_ROPE)), f32) * MLA_Q_RANK ** -0.5,
        "g_kv": 1.0 + 0.1 * nrm(ks[9], (L, MLA_KV_RANK), f32),
        "w_ukv": nrm(ks[10], (L, MLA_KV_RANK, MLA_HEADS * (MLA_NOPE + MLA_V)), f32) * MLA_KV_RANK ** -0.5,
        "sink": nrm(ks[11], (L, SWA_HEADS), f32) * 0.5,
        "lam_q1": nrm(ks[12], (L, DIFF_HEAD_DIM), f32) * 0.1,
        "lam_k1": nrm(ks[13], (L, DIFF_HEAD_DIM), f32) * 0.1,
        "lam_q2": nrm(ks[14], (L, DIFF_HEAD_DIM), f32) * 0.1,
        "lam_k2": nrm(ks[15], (L, DIFF_HEAD_DIM), f32) * 0.1,
        "g_sub": 1.0 + 0.1 * nrm(ks[16], (L, 2 * DIFF_HEAD_DIM), f32),
        "w_o_mla": nrm(ks[17], (L, MLA_WIDTH, D), f32) * MLA_WIDTH ** -0.5,
        "w_o_swa": nrm(ks[18], (L, SWA_WIDTH, D), f32) * SWA_WIDTH ** -0.5,
        "w_o_diff": nrm(ks[19], (L, DIFF_WIDTH, D), f32) * DIFF_WIDTH ** -0.5,
        "w_out": nrm(ks[20], (L, D, D), f32) * D ** -0.5,
        "rel_bias": nrm(ks[21], (REL_BUCKETS, REL_HEADS), f32) * 0.5,
    }


def reference(x, c, w_ada, b_ada, g_pre, g_post, w_in, g_q, w_uq, g_kv, w_ukv, sink,
              lam_q1, lam_k1, lam_q2, lam_k2, g_sub, w_o_mla, w_o_swa, w_o_diff, w_out, rel_bias):
    B, S, D = x.shape
    pos = jnp.arange(S, dtype=jnp.float32)
    inv = ROPE_THETA ** (-jnp.arange(0, MLA_ROPE, 2, dtype=jnp.float32) / MLA_ROPE)
    ang = pos[:, None] * inv[None, :]
    cos, sin = jnp.cos(ang), jnp.sin(ang)
    rel_band = jnp.arange(3 * BLOCK)[None, :] - BLOCK - jnp.arange(BLOCK)[:, None]
    swa_bias = rel_bias[t5_bucket(rel_band)][..., :SWA_HEADS].astype(jnp.float32).transpose(2, 0, 1)
    c_act = jax.nn.silu(c)

    for l in range(DEPTH):
        mod = c_act @ w_ada[l] + b_ada[l]
        shift, scale, gate = [m[:, None, :] for m in split_cols(mod, (D, D, D))]
        h = rms_norm(x, g_pre[l]) * (1.0 + scale) + shift
        (cq, ckv, kr, za, qb_, kb_, vb_, zb, qc, kc, vc, zc, gcols) = split_cols(h @ w_in[l], IN_SPLITS)

        o_a = (mla_branch(cq, ckv, kr, g_q[l], w_uq[l], g_kv[l], w_ukv[l], cos, sin)
               * jax.nn.silu(za)) @ w_o_mla[l]
        o_b = (swa_branch(qb_, kb_, vb_, sink[l], swa_bias) * jax.nn.silu(zb)) @ w_o_swa[l]
        lam_init = 0.8 - 0.6 * math.exp(-0.3 * l)
        o_c = (diff_branch(qc, kc, vc, lam_q1[l], lam_k1[l], lam_q2[l], lam_k2[l], g_sub[l],
                           rel_bias, lam_init) * jax.nn.silu(zc)) @ w_o_diff[l]

        g = jax.nn.sigmoid(gcols).reshape(B, S, N_BRANCH, D)
        y = (g[:, :, 0] * o_a + g[:, :, 1] * o_b + g[:, :, 2] * o_c) @ w_out[l]
        x = x + gate * rms_norm(y, g_post[l])
    return x
```

```cpp
#include <hip/hip_runtime.h>
#include <hip/hip_cooperative_groups.h>
#include <cstdio>
#include <cstdint>
#include <cmath>
namespace cg = cooperative_groups;

#ifndef SINGLE_LAUNCH
#define SINGLE_LAUNCH 1
#endif

typedef unsigned short u16;
typedef unsigned int u32;
typedef short bf16x8 __attribute__((ext_vector_type(8)));
typedef float f32x16 __attribute__((ext_vector_type(16)));
typedef unsigned int u32x4 __attribute__((ext_vector_type(4)));
typedef unsigned int u32x2 __attribute__((ext_vector_type(2)));
#define DI __device__ __forceinline__
#define MFMA(a, b, c) __builtin_amdgcn_mfma_f32_32x32x16_bf16((a), (b), (c), 0, 0, 0)

constexpr int D = 1024, NB = 8, S = 4096, T = NB * S, DEPTH = 4, INC = 7328;
constexpr float LOG2E = 1.4426950408889634f;
constexpr float EPS = 1e-6f;
#ifdef PROBE_GEMM2
constexpr int PPL = 10; constexpr unsigned long long PSEQ = 0x5443321100ull;
#else
constexpr int PPL = 6; constexpr unsigned long long PSEQ = 0x543210ull;
#endif
constexpr int NPHASE = 2 + PPL * DEPTH;

constexpr size_t MiB = 1048576;
constexpr size_t OFF_MOD = 256;
constexpr size_t OFF_ROPE = OFF_MOD + 393216;
constexpr size_t OFF_BT = OFF_ROPE + 524288;
constexpr size_t OFF_LAM = OFF_BT + 28672;
constexpr int BTS = 584, BTN = 577, BTO = 288;
constexpr size_t OFF_BAR = 983040;
constexpr size_t OFF_W = 1 * MiB;
constexpr size_t W_P1 = OFF_W;
constexpr size_t W_G = W_P1 + 4352ull * 1024 * 2;
constexpr size_t W_UQ = W_G + 3072ull * 1024 * 2;
constexpr size_t W_UKV = W_UQ + 768ull * 256 * 2;
constexpr size_t W_O = W_UKV + 1024ull * 128 * 2;
constexpr size_t W_OUT = W_O + 3ull * 1024 * 512 * 2;
constexpr size_t OFF_ACT = 23 * MiB;
constexpr size_t A_H = OFF_ACT;
constexpr size_t A_CQ = A_H + 64 * MiB;
constexpr size_t A_Z = A_CQ + 24 * MiB;
constexpr size_t A_SQ = A_Z + 96 * MiB;
constexpr size_t A_SK = A_SQ + 32 * MiB;
constexpr size_t A_SVT = A_SK + 8 * MiB;
constexpr size_t A_DQ = A_SVT + 8 * MiB;
constexpr size_t A_DK = A_DQ + 32 * MiB;
constexpr size_t A_DVT = A_DK + 32 * MiB;
constexpr size_t A_MQ = A_DVT + 32 * MiB;
constexpr size_t A_KM = A_MQ + 48 * MiB;
constexpr size_t A_MVT = A_KM + 48 * MiB;
constexpr size_t A_O0 = A_MVT + 32 * MiB;
constexpr size_t WS_END = A_O0 + 32 * MiB;
constexpr size_t A_M = A_DQ;
constexpr size_t A_Y = A_MQ;
static_assert(W_OUT + 1024ull * 1024 * 2 <= OFF_ACT, "weights overflow");

struct Params {
  const float* in[22];
  float* out;
  unsigned char* ws;
  float inv_freq[16];
  float lam_init[4];
  int ph_lo, ph_hi;
};

#ifndef SKEW_ATT
#define SKEW_ATT 12
#endif
constexpr int SMEM_BYTES = 66048;
constexpr int SM_AUX = 36864;
constexpr int SM_ATT_V = 26624;
constexpr int SM_ATT_B = 63488;

typedef float f32x2_ __attribute__((ext_vector_type(2)));
typedef __bf16 bf16x2_ __attribute__((ext_vector_type(2)));
DI u32 pk2(float lo, float hi) { f32x2_ v = {lo, hi}; bf16x2_ r = __builtin_convertvector(v, bf16x2_); return __builtin_bit_cast(u32, r); }
DI u16 f2bf(float x) { return (u16)(pk2(x, 0.f) & 0xffffu); }
DI float bflo(u32 v) { return __uint_as_float(v << 16); }
DI float bfhi(u32 v) { return __uint_as_float(v & 0xffff0000u); }
DI unsigned char* launder_ptr(const void* q) {
  unsigned long long v = (unsigned long long)q;
  u32 lo = (u32)v, hi = (u32)(v >> 32);
  asm volatile("" : "+v"(lo), "+v"(hi));
  lo = __builtin_amdgcn_readfirstlane(lo); hi = __builtin_amdgcn_readfirstlane(hi);
  return (unsigned char*)(((unsigned long long)hi << 32) | lo);
}
struct Params;
DI int opaque_uniform(int i) { asm volatile("" : "+v"(i)); return __builtin_amdgcn_readfirstlane(i); }
#define PIN(k) (p.in[opaque_uniform(k)])
#define FRESH_TID(v, wv) unsigned v##z = 0u; asm volatile("" : "+v"(v##z)); const int v = ((wv) << 6) | (int)__builtin_amdgcn_mbcnt_hi(~0u, __builtin_amdgcn_mbcnt_lo(~0u, v##z))
#define BIDX opaque_uniform((int)blockIdx.x)
#define GDIM opaque_uniform((int)gridDim.x)
DI float fexp2(float x) { return __builtin_amdgcn_exp2f(x); }
DI float frcp(float x) { return __builtin_amdgcn_rcpf(x); }
DI float sigmoidf_(float x) { return frcp(1.f + fexp2(-x * LOG2E)); }
DI float siluf_(float x) { return x * sigmoidf_(x); }
DI int crow(int i, int h) { return (i & 3) + 8 * (i >> 2) + 4 * h; }
DI float lane_xor(int lane, float v, int m) { return __int_as_float(__builtin_amdgcn_ds_bpermute((lane ^ m) << 2, __float_as_int(v))); }
DI float wave_sum(int lane, float v) {
#pragma unroll
  for (int m = 32; m >= 1; m >>= 1) v += lane_xor(lane, v, m);
  return v;
}
DI float xhalf_max(float v) { auto rr = __builtin_amdgcn_permlane32_swap(__float_as_uint(v), __float_as_uint(v), false, false); return fmaxf(__uint_as_float(rr[0]), __uint_as_float(rr[1])); }
DI float xhalf_sum(float v) { auto rr = __builtin_amdgcn_permlane32_swap(__float_as_uint(v), __float_as_uint(v), false, false); return __uint_as_float(rr[0]) + __uint_as_float(rr[1]); }

template <int MT>
DI void gemm_loop(const int tid__, f32x16 (&acc)[2][MT], const u16* __restrict__ Wp, int ldw, const u16* __restrict__ Xp, int ldx, int K, u16* sW, u16* sX) {
  const int tid = tid__, lane = tid & 63, wave = tid >> 6;
  const int r = lane & 31, h = lane >> 5, wn = wave & 1, wm = wave >> 1;
  const int lrow = tid >> 3, lch = tid & 7;
  const unsigned wo = (unsigned)(lrow * ldw + lch * 8) * 2u, xo = (unsigned)(lrow * ldx + lch * 8) * 2u;
  const unsigned so = (unsigned)(lrow * 72 + lch * 8) * 2u;
  const char* wb = (const char*)Wp; const char* xb = (const char*)Xp;
  u32x4 rw[4], rx[2 * MT];
#pragma unroll
  for (int i = 0; i < 4; ++i) rw[i] = *(const u32x4*)(wb + (size_t)(32 * i * ldw) * 2 + wo);
#pragma unroll
  for (int i = 0; i < 2 * MT; ++i) rx[i] = *(const u32x4*)(xb + (size_t)(32 * i * ldx) * 2 + xo);
  const int nkt = K >> 6;
  const unsigned fa = (unsigned)((wn * 64 + r) * 72 + h * 8) * 2u, fb = (unsigned)((wm * 32 * MT + r) * 72 + h * 8) * 2u;
  for (int kt = 0; kt < nkt; ++kt) {
    __syncthreads();
#pragma unroll
    for (int i = 0; i < 4; ++i) *(u32x4*)((char*)sW + so + i * (32 * 72 * 2)) = rw[i];
#pragma unroll
    for (int i = 0; i < 2 * MT; ++i) *(u32x4*)((char*)sX + so + i * (32 * 72 * 2)) = rx[i];
    __syncthreads();
    {
      const int k0 = (kt + 1 < nkt ? kt + 1 : kt) * 64;
#pragma unroll
      for (int i = 0; i < 4; ++i) rw[i] = *(const u32x4*)(wb + (size_t)(32 * i * ldw + k0) * 2 + wo);
#pragma unroll
      for (int i = 0; i < 2 * MT; ++i) rx[i] = *(const u32x4*)(xb + (size_t)(32 * i * ldx + k0) * 2 + xo);
    }
    __builtin_amdgcn_sched_barrier(0);
#pragma unroll
    for (int ks = 0; ks < 4; ++ks) {
      bf16x8 a[2], b[MT];
#pragma unroll
      for (int q = 0; q < 2; ++q) a[q] = *(const bf16x8*)((const char*)sW + fa + q * (32 * 72 * 2) + ks * 32);
#pragma unroll
      for (int q = 0; q < MT; ++q) b[q] = *(const bf16x8*)((const char*)sX + fb + q * (32 * 72 * 2) + ks * 32);
#pragma unroll
      for (int ni = 0; ni < 2; ++ni)
#pragma unroll
        for (int mi = 0; mi < MT; ++mi) acc[ni][mi] = MFMA(a[ni], b[mi], acc[ni][mi]);
    }
  }
}
template <int MT> struct GStage { u32x4 rw[4]; u32x4 rx[2 * MT]; };
template <int MT>
DI void gemm_prefetch(const int tid__, GStage<MT>& st, const u16* __restrict__ Wp, int ldw, const u16* __restrict__ Xp, int ldx) {
  const int lrow = tid__ >> 3, lch = tid__ & 7;
  const unsigned wo = (unsigned)(lrow * ldw + lch * 8) * 2u, xo = (unsigned)(lrow * ldx + lch * 8) * 2u;
#pragma unroll
  for (int i = 0; i < 4; ++i) st.rw[i] = *(const u32x4*)((const char*)Wp + (size_t)(32 * i * ldw) * 2 + wo);
#pragma unroll
  for (int i = 0; i < 2 * MT; ++i) st.rx[i] = *(const u32x4*)((const char*)Xp + (size_t)(32 * i * ldx) * 2 + xo);
}
template <int MT>
DI void gemm_loop_chain(const int tid__, f32x16 (&acc)[2][MT], GStage<MT>& st, const u16* __restrict__ Wp, int ldw, const u16* __restrict__ Xp, int ldx, int K, u16* sW, u16* sX,
                        const u16* __restrict__ Wn, int ldwn, const u16* __restrict__ Xn, int ldxn) {
  const int tid = tid__, lane = tid & 63, wave = tid >> 6;
  const int r = lane & 31, h = lane >> 5, wn = wave & 1, wm = wave >> 1;
  const int lrow = tid >> 3, lch = tid & 7;
  const unsigned so = (unsigned)(lrow * 72 + lch * 8) * 2u;
  const int nkt = K >> 6;
  const unsigned fa = (unsigned)((wn * 64 + r) * 72 + h * 8) * 2u, fb = (unsigned)((wm * 32 * MT + r) * 72 + h * 8) * 2u;
  for (int kt = 0; kt < nkt; ++kt) {
    __syncthreads();
#pragma unroll
    for (int i = 0; i < 4; ++i) *(u32x4*)((char*)sW + so + i * (32 * 72 * 2)) = st.rw[i];
#pragma unroll
    for (int i = 0; i < 2 * MT; ++i) *(u32x4*)((char*)sX + so + i * (32 * 72 * 2)) = st.rx[i];
    __syncthreads();
    {
      const bool last = kt + 1 >= nkt;
      const char* wb = last ? (const char*)Wn : (const char*)Wp + (size_t)(kt + 1) * 128;
      const char* xb = last ? (const char*)Xn : (const char*)Xp + (size_t)(kt + 1) * 128;
      const int lw = last ? ldwn : ldw, lx = last ? ldxn : ldx;
      const unsigned wo = (unsigned)(lrow * lw + lch * 8) * 2u, xo = (unsigned)(lrow * lx + lch * 8) * 2u;
#pragma unroll
      for (int i = 0; i < 4; ++i) st.rw[i] = *(const u32x4*)(wb + (size_t)(32 * i * lw) * 2 + wo);
#pragma unroll
      for (int i = 0; i < 2 * MT; ++i) st.rx[i] = *(const u32x4*)(xb + (size_t)(32 * i * lx) * 2 + xo);
    }
    __builtin_amdgcn_sched_barrier(0);
#pragma unroll
    for (int ks = 0; ks < 4; ++ks) {
      bf16x8 a[2], b[MT];
#pragma unroll
      for (int q = 0; q < 2; ++q) a[q] = *(const bf16x8*)((const char*)sW + fa + q * (32 * 72 * 2) + ks * 32);
#pragma unroll
      for (int q = 0; q < MT; ++q) b[q] = *(const bf16x8*)((const char*)sX + fb + q * (32 * 72 * 2) + ks * 32);
#pragma unroll
      for (int ni = 0; ni < 2; ++ni)
#pragma unroll
        for (int mi = 0; mi < MT; ++mi) acc[ni][mi] = MFMA(a[ni], b[mi], acc[ni][mi]);
    }
  }
}
template <int MT> DI void zero_acc(f32x16 (&acc)[2][MT]) {
#pragma unroll
  for (int a = 0; a < 2; ++a)
#pragma unroll
    for (int b = 0; b < MT; ++b)
#pragma unroll
      for (int i = 0; i < 16; ++i) acc[a][b][i] = 0.f;
}
struct FId { DI float operator()(float x) const { return x; } };
struct FSilu { DI float operator()(float x) const { return siluf_(x); } };
struct FScale { float s; DI float operator()(float x) const { return x * s; } };
template <int MT, int E = 0, class F = FId> DI void stage_normal(const int tid__, const f32x16 (&acc)[2][MT], u16* sC, F f = F()) {
  const int lane = tid__ & 63, wave = tid__ >> 6, r = lane & 31, h = lane >> 5, wn = wave & 1, wm = wave >> 1;
#pragma unroll
  for (int ni = 0; ni < 2; ++ni)
#pragma unroll
    for (int mj = 0; mj < 2; ++mj)
#pragma unroll
      for (int g = 0; g < 4; ++g) {
        const int n = wn * 64 + ni * 32 + 8 * g + 4 * h, tok = wm * 64 + mj * 32 + r;
        u32x2 v;
        constexpr int MB = (MT == 2 || E == 0) ? 0 : MT - 2;
        v.x = pk2(f(acc[ni][MB + mj][4 * g]), f(acc[ni][MB + mj][4 * g + 1])); v.y = pk2(f(acc[ni][MB + mj][4 * g + 2]), f(acc[ni][MB + mj][4 * g + 3]));
        *(u32x2*)(sC + tok * 136 + n) = v;
      }
}
template <int MT, int E = 0> DI void stage_transposed(const int tid__, const f32x16 (&acc)[2][MT], u16* sCt) {
  const int lane = tid__ & 63, wave = tid__ >> 6, r = lane & 31, h = lane >> 5, wn = wave & 1, wm = wave >> 1;
#pragma unroll
  for (int ni = 0; ni < 2; ++ni)
#pragma unroll
    for (int mj = 0; mj < 2; ++mj)
#pragma unroll
      for (int i = 0; i < 16; ++i) {
        const int n = wn * 64 + ni * 32 + crow(i, h), tok = wm * 64 + mj * 32 + r;
        constexpr int MB = (MT == 2 || E == 0) ? 0 : MT - 2;
        const float v = acc[ni][MB + mj][i];
        sCt[n * 136 + tok] = f2bf(v);
      }
}
template <class F> DI void store_rows(const int tid__, const u16* sC, u16* dst, int ld, F colfn, int rs = 0) {
  const int tid = tid__, ch = tid & 15, r0 = tid >> 4;
  const unsigned lo = (unsigned)(r0 * ld + colfn(ch * 8)) * 2u;
#pragma unroll
  for (int it = 0; it < 8; ++it) {
    const u32x4 v = *(const u32x4*)((const char*)sC + (unsigned)((r0 * 136 + ch * 8) * 2) + it * (16 * 136 * 2));
    *(u32x4*)((char*)dst + (size_t)((16 * it + (it >> 2) * rs) * ld) * 2 + lo) = v;
  }
}
struct ColId { DI int operator()(int c) const { return c; } };
struct ColTok { DI int operator()(int c) const { return (c >> 6) * 128 + (c & 63); } };

DI void conv_tile(const int tid__, const float* __restrict__ src, int ld, int srccol, int k0, const float* __restrict__ kscale, u16* __restrict__ dst, int K, int n0, u16* sm, int kmask = 0x7fffffff, float kmul = 1.f) {
  const int tid = tid__, col = tid & 31, rw = tid >> 5;
  __syncthreads();
  float vv[16];
#pragma unroll
  for (int i = 0; i < 16; ++i) {
    const int k = rw + 8 * i;
    vv[i] = 0.f;
    if (srccol >= 0) { vv[i] = src[(size_t)(k0 + k) * ld + srccol + col]; if (kscale) vv[i] *= kscale[(k0 + k) & kmask] * kmul; }
  }
#pragma unroll
  for (int i = 0; i < 16; ++i) sm[col * 136 + rw + 8 * i] = f2bf(vv[i]);
  __syncthreads();
  const int n = tid >> 3, ch = tid & 7;
#pragma unroll
  for (int it = 0; it < 2; ++it) {
    const int c = ch + 8 * it;
    const u32x4 v = *(const u32x4*)(sm + n * 136 + c * 8);
    *(u32x4*)(dst + (size_t)(n0 + n) * K + k0 + c * 8) = v;
  }
}
constexpr int CONV_JOBS = 1088 + 768 + 48 + 32 + 384 + 256;
DI void conv_job(const int tid__, const Params& p, int l, int jid, u16* sm) {
  unsigned char* ws = p.ws;
  if (jid < 1088) {
    const int tj = jid >> 3, kt = jid & 7;
    const int sc = tj < 13 ? 32 * tj : (tj < 16 ? -1 : 32 * (tj - 3));
    conv_tile(tid__, PIN(6) + (size_t)l * D * INC, INC, sc, kt * 128, nullptr, (u16*)(ws + W_P1), 1024, tj * 32, sm);
    return;
  }
  jid -= 1088;
  if (jid < 768) {
    const int tj = jid >> 3, kt = jid & 7;
    conv_tile(tid__, PIN(6) + (size_t)l * D * INC, INC, 4256 + 32 * tj, kt * 128, nullptr, (u16*)(ws + W_G), 1024, tj * 32, sm);
    return;
  }
  jid -= 768;
  if (jid < 48) {
    const int tj = jid >> 1, kt = jid & 1;
    conv_tile(tid__, PIN(8) + (size_t)l * 256 * 768, 768, 32 * tj, kt * 128, PIN(7) + l * 256, (u16*)(ws + W_UQ), 256, tj * 32, sm);
    return;
  }
  jid -= 48;
  if (jid < 32) {
    const int tj = jid;
    const int sc = tj < 16 ? (tj >> 1) * 128 + (tj & 1) * 32 : ((tj - 16) >> 1) * 128 + 64 + ((tj - 16) & 1) * 32;
    conv_tile(tid__, PIN(10) + (size_t)l * 128 * 1024, 1024, sc, 0, PIN(9) + l * 128, (u16*)(ws + W_UKV), 128, tj * 32, sm);
    return;
  }
  jid -= 32;
  if (jid < 384) {
    const int which = jid >> 7, jj = jid & 127, tj = jj >> 2, kt = jj & 3;
    conv_tile(tid__, PIN(17 + which) + (size_t)l * 512 * 1024, 1024, 32 * tj, kt * 128, which == 2 ? PIN(16) + l * 128 : nullptr, (u16*)(ws + W_O) + (size_t)which * 1024 * 512, 512, tj * 32, sm, 127, 1.f - p.lam_init[opaque_uniform(l)]);
    return;
  }
  jid -= 384;
  {
    const int tj = jid >> 3, kt = jid & 7;
    conv_tile(tid__, PIN(20) + (size_t)l * 1024 * 1024, 1024, 32 * tj, kt * 128, nullptr, (u16*)(ws + W_OUT), 1024, tj * 32, sm);
  }
}

DI void phase0(const int wvu__, const Params& p, unsigned char* smem) {
  FRESH_TID(tid__, wvu__);
  const int bid_ = BIDX, gd_ = GDIM;
  const int tid = tid__;
  constexpr int NJ = CONV_JOBS + 192 + 16 + 1;
  for (int job = bid_; job < NJ; job += gd_) {
    if (job < CONV_JOBS) { conv_job(tid__, p, 0, job, (u16*)smem); continue; }
    int j = job - CONV_JOBS;
    if (j < 192) {
      const int l = j / 48, cj = j % 48;
      float* sc = (float*)smem;
      float* red = (float*)(smem + 32768);
      __syncthreads();
      for (int e = tid; e < 8192; e += 256) sc[e] = siluf_(PIN(1)[e]);
      __syncthreads();
      const int col = tid & 63, kq = tid >> 6;
      const float* w = PIN(2) + (size_t)l * D * 3072 + cj * 64 + col;
      float a[8];
#pragma unroll
      for (int b = 0; b < 8; ++b) a[b] = 0.f;
      for (int k = kq * 256; k < kq * 256 + 256; ++k) {
        const float wv = w[(size_t)k * 3072];
#pragma unroll
        for (int b = 0; b < 8; ++b) a[b] += sc[b * 1024 + k] * wv;
      }
#pragma unroll
      for (int b = 0; b < 8; ++b) red[(kq * 8 + b) * 64 + col] = a[b];
      __syncthreads();
      float* mod = (float*)(p.ws + OFF_MOD);
      for (int e = tid; e < 512; e += 256) {
        const int b = e >> 6, c = e & 63;
        const float v = red[(0 * 8 + b) * 64 + c] + red[(1 * 8 + b) * 64 + c] + red[(2 * 8 + b) * 64 + c] + red[(3 * 8 + b) * 64 + c];
        mod[((size_t)l * 8 + b) * 3072 + cj * 64 + c] = v + PIN(3)[l * 3072 + cj * 64 + c];
      }
      continue;
    }
    j -= 192;
    if (j < 16) {
      float2* rt = (float2*)(p.ws + OFF_ROPE);
      for (int e = j * 4096 + tid; e < (j + 1) * 4096; e += 256) {
        const int pos = e >> 4, i = e & 15;
        const float ang = (float)pos * p.inv_freq[i];
        const double rev = (double)ang * 0.15915494309189535;
        const float fr = (float)(rev - floor(rev));
        rt[e] = make_float2(__builtin_amdgcn_cosf(fr), __builtin_amdgcn_sinf(fr));
      }
      continue;
    }
    {
      float* bt = (float*)(p.ws + OFF_BT);
      for (int e = tid; e < 12 * BTN; e += 256) {
        const int hh = e / BTN, idx = e % BTN, rel = idx - BTO;
        const int n = rel < 0 ? -rel : rel;
        int bucket = rel > 0 ? 16 : 0;
        if (n < 8) bucket += n;
        else { int k = 8 + (31 - __clz(n * n)) - 6; bucket += k > 15 ? 15 : k; }
        float v = PIN(21)[bucket * 12 + hh] * LOG2E;
        if (hh < 8 && n > 128) v = -1e30f;
        bt[hh * BTS + idx] = v;
      }
      if (tid < 4) {
        const int l = tid;
        float s1 = 0.f, s2 = 0.f;
        for (int i = 0; i < 64; ++i) { s1 += PIN(12)[l * 64 + i] * PIN(13)[l * 64 + i]; s2 += PIN(14)[l * 64 + i] * PIN(15)[l * 64 + i]; }
        ((float*)(p.ws + OFF_LAM))[l] = expf(s1) - expf(s2) + p.lam_init[l];
      }
    }
  }
}

DI void phase_norm(const int wvu__, const Params& p, int l, unsigned char* smem) {
  FRESH_TID(tid__, wvu__);
  const int bid_ = BIDX, gd_ = GDIM;
  if (l >= 0 && l + 1 < DEPTH)
    for (int job = bid_; job < CONV_JOBS; job += gd_) conv_job(tid__, p, l + 1, job, (u16*)smem);
  const int lane = tid__ & 63, wave = tid__ >> 6;
  const float* xsrc = (l <= 0) ? PIN(0) : p.out;
  const float* mod = (const float*)(p.ws + OFF_MOD);
  const u16* Y = (const u16*)(p.ws + A_Y);
  u16* H = (u16*)(p.ws + A_H);
  for (int row = bid_ * 4 + wave; row < T; row += gd_ * 4) {
    const int b = row >> 12;
    float4 xv[4];
#pragma unroll
    for (int i = 0; i < 4; ++i) xv[i] = *(const float4*)(xsrc + (size_t)row * D + lane * 4 + 256 * i);
    if (l >= 0) {
      float yv[4][4];
      float ss = 0.f;
#pragma unroll
      for (int i = 0; i < 4; ++i) {
        const u32x2 t = *(const u32x2*)(Y + (size_t)row * D + lane * 4 + 256 * i);
        yv[i][0] = bflo(t.x); yv[i][1] = bfhi(t.x); yv[i][2] = bflo(t.y); yv[i][3] = bfhi(t.y);
        ss += yv[i][0] * yv[i][0] + yv[i][1] * yv[i][1] + yv[i][2] * yv[i][2] + yv[i][3] * yv[i][3];
      }
      ss = wave_sum(lane, ss);
      const float rstd = rsqrtf(ss * (1.f / 1024.f) + EPS);
      const float* gate = mod + ((size_t)l * 8 + b) * 3072 + 2048;
      const float* gp = PIN(5) + l * D;
#pragma unroll
      for (int i = 0; i < 4; ++i) {
        const int c = lane * 4 + 256 * i;
        const float4 gt = *(const float4*)(gate + c), gg = *(const float4*)(gp + c);
        xv[i].x += gt.x * (yv[i][0] * rstd * gg.x); xv[i].y += gt.y * (yv[i][1] * rstd * gg.y);
        xv[i].z += gt.z * (yv[i][2] * rstd * gg.z); xv[i].w += gt.w * (yv[i][3] * rstd * gg.w);
        *(float4*)(p.out + (size_t)row * D + c) = xv[i];
      }
    }
    if (l + 1 < DEPTH) {
      float ss = 0.f;
#pragma unroll
      for (int i = 0; i < 4; ++i) ss += xv[i].x * xv[i].x + xv[i].y * xv[i].y + xv[i].z * xv[i].z + xv[i].w * xv[i].w;
      ss = wave_sum(lane, ss);
      const float rstd = rsqrtf(ss * (1.f / 1024.f) + EPS);
      const float* sh = mod + ((size_t)(l + 1) * 8 + b) * 3072;
      const float* gp = PIN(4) + (l + 1) * D;
#pragma unroll
      for (int i = 0; i < 4; ++i) {
        const int c = lane * 4 + 256 * i;
        const float4 s0 = *(const float4*)(sh + c), s1 = *(const float4*)(sh + 1024 + c), gg = *(const float4*)(gp + c);
        const float h0 = xv[i].x * rstd * gg.x * (1.f + s1.x) + s0.x, h1 = xv[i].y * rstd * gg.y * (1.f + s1.y) + s0.y;
        const float h2 = xv[i].z * rstd * gg.z * (1.f + s1.z) + s0.z, h3 = xv[i].w * rstd * gg.w * (1.f + s1.w) + s0.w;
        u32x2 o; o.x = pk2(h0, h1); o.y = pk2(h2, h3);
        *(u32x2*)(H + (size_t)row * D + c) = o;
      }
    }
  }
}

constexpr float QS64 = 0.125f * LOG2E;
constexpr float QS96 = 0.10206207261596575f * LOG2E;
template <int MT> DI void scale_acc(f32x16 (&acc)[2][MT], float s) {
#pragma unroll
  for (int a = 0; a < 2; ++a)
#pragma unroll
    for (int b = 0; b < MT; ++b)
#pragma unroll
      for (int i = 0; i < 16; ++i) acc[a][b][i] *= s;
}
template <int MT> DI void silu_acc(f32x16 (&acc)[2][MT]) {
#pragma unroll
  for (int a = 0; a < 2; ++a)
#pragma unroll
    for (int b = 0; b < MT; ++b)
#pragma unroll
      for (int i = 0; i < 16; ++i) acc[a][b][i] = siluf_(acc[a][b][i]);
}
DI void rope_tile(f32x16& t, int pos, int h, const float2* __restrict__ rt) {
#pragma unroll
  for (int i = 0; i < 8; ++i) {
    const int f = (i & 3) + 8 * (i >> 2) + 4 * h;
    const float2 cs = rt[pos * 16 + f];
    const float x1 = t[i], x2 = t[i + 8];
    t[i] = x1 * cs.x - x2 * cs.y;
    t[i + 8] = x2 * cs.x + x1 * cs.y;
  }
}
template <int E>
DI void p1_epi(const int tid__, const f32x16 (&acc)[2][4], u16* sC, int mode, u16* dst, int ld) {
  __syncthreads();
  if (mode == 3) {
    stage_transposed<4, E>(tid__, acc, sC); __syncthreads();
    store_rows(tid__, sC, dst + E * 64, ld, ColTok());
  } else {
    if (mode == 1) stage_normal<4, E, FSilu>(tid__, acc, sC);
    else if (mode == 2) { FScale fs; fs.s = QS64; stage_normal<4, E, FScale>(tid__, acc, sC, fs); }
    else stage_normal<4, E>(tid__, acc, sC);
    __syncthreads();
    if (mode == 4) {
      for (int idx = tid__; idx < 512; idx += 256) {
        const int row = idx >> 2, ch = idx & 3;
        const u32x4 v = *(const u32x4*)(sC + row * 136 + ch * 8);
        u16* kr = dst + (size_t)((row >> 6) * 128 + E * 64 + (row & 63)) * 768 + 64 + ch * 8;
#pragma unroll
        for (int hd = 0; hd < 8; ++hd) *(u32x4*)(kr + hd * 96) = v;
      }
    } else store_rows(tid__, sC, dst + (size_t)(E * 64) * ld, ld, ColId(), 64);
  }
}
DI void phase_p1(const int wvu__, const Params& p, unsigned char* smem) {
  FRESH_TID(tid__, wvu__);
  const int bid_ = BIDX, gd_ = GDIM;
  unsigned char* ws = p.ws;
  u16* sW = (u16*)smem; u16* sX = (u16*)(smem + 18432); u16* sC = (u16*)smem;
  const int lane = tid__ & 63, wave = tid__ >> 6, r = lane & 31, h = lane >> 5, wn = wave & 1, wm = wave >> 1;
  const float2* rt = (const float2*)(ws + OFF_ROPE);
  for (int jl = bid_ >> 3; jl < 16 * 34; jl += gd_ >> 3) {
    const int g8 = jl / 136, q8 = jl % 136;
    const int mt = (g8 * 4 + (q8 & 3)) * 8 + (bid_ & 7), j = q8 >> 2, m0 = mt * 256;
    f32x16 acc[2][4];
    zero_acc<4>(acc);
    gemm_loop<4>(tid__, acc, (const u16*)(ws + W_P1) + (size_t)j * 128 * 1024, 1024, (const u16*)(ws + A_H) + (size_t)m0 * 1024, 1024, 1024, sW, sX);
    const int b = m0 >> 12, s0 = m0 & 4095;
    int mode = 0; u16* dst; int ld;
    if (j < 3) { dst = (u16*)(ws + A_CQ) + (size_t)m0 * 384 + j * 128; ld = 384; }
    else if (j == 3) { mode = 4; dst = (u16*)(ws + A_KM) + (size_t)m0 * 768; ld = 768; }
    else if (j < 8) { mode = 1; dst = (u16*)(ws + A_Z) + (size_t)m0 * 1536 + (j - 4) * 128; ld = 1536; }
    else if (j < 12) { mode = 2; dst = (u16*)(ws + A_SQ) + (size_t)m0 * 512 + (j - 8) * 128; ld = 512; }
    else if (j == 12) { dst = (u16*)(ws + A_SK) + (size_t)m0 * 128; ld = 128; }
    else if (j == 13) { mode = 3; dst = (u16*)(ws + A_SVT) + (size_t)(b * 128) * S + s0; ld = S; }
    else if (j < 18) { mode = 1; dst = (u16*)(ws + A_Z) + (size_t)m0 * 1536 + 512 + (j - 14) * 128; ld = 1536; }
    else if (j < 22) { mode = 2; dst = (u16*)(ws + A_DQ) + (size_t)m0 * 512 + (j - 18) * 128; ld = 512; }
    else if (j < 26) { dst = (u16*)(ws + A_DK) + (size_t)m0 * 512 + (j - 22) * 128; ld = 512; }
    else if (j < 30) { mode = 3; dst = (u16*)(ws + A_DVT) + (size_t)(b * 512 + (j - 26) * 128) * S + s0; ld = S; }
    else { mode = 1; dst = (u16*)(ws + A_Z) + (size_t)m0 * 1536 + 1024 + (j - 30) * 128; ld = 1536; }
    if (mode == 4 && wn == 0) {
#pragma unroll
      for (int mi = 0; mi < 4; ++mi) rope_tile(acc[0][mi], s0 + wm * 128 + mi * 32 + r, h, rt);
    }
    p1_epi<0>(tid__, acc, sC, mode, dst, ld);
    p1_epi<1>(tid__, acc, sC, mode, dst, ld);
  }
}

struct ColKM { int base; DI int operator()(int c) const { return (base + (c >> 6)) * 96 + (c & 63); } };
template <int E>
DI void p2_epi(const int tid__, const f32x16 (&acc)[2][4], u16* sC, unsigned char* ws, bool isq, int nt, int m0, int b, int s0) {
  __syncthreads();
  if (isq) {
    stage_normal<4, E>(tid__, acc, sC); __syncthreads();
    store_rows(tid__, sC, (u16*)(ws + A_MQ) + (size_t)(m0 + E * 64) * 768 + nt * 128, 768, ColId(), 64);
  } else if (nt - 6 < 4) {
    stage_normal<4, E>(tid__, acc, sC); __syncthreads();
    ColKM cm; cm.base = (nt - 6) * 2;
    store_rows(tid__, sC, (u16*)(ws + A_KM) + (size_t)(m0 + E * 64) * 768, 768, cm, 64);
  } else {
    stage_transposed<4, E>(tid__, acc, sC); __syncthreads();
    store_rows(tid__, sC, (u16*)(ws + A_MVT) + (size_t)(b * 512 + (nt - 10) * 128) * S + s0 + E * 64, S, ColTok());
  }
}
DI void phase_p2(const int wvu__, const Params& p, unsigned char* smem) {
  const int bid_ = BIDX, gd_ = GDIM;
  unsigned char* ws = p.ws;
  u16* sW = (u16*)smem; u16* sX = (u16*)(smem + 18432); u16* sC = (u16*)smem;
  float* sR = (float*)(smem + 55296);
  const float2* rt = (const float2*)(ws + OFF_ROPE);
  const u16* CQ = (const u16*)(ws + A_CQ);
  for (int jl = bid_ >> 3; jl < 16 * 14; jl += gd_ >> 3) {
    FRESH_TID(tid__, wvu__);
    const int tid = tid__, lane = tid & 63, wave = tid >> 6, r = lane & 31, h = lane >> 5, wn = wave & 1, wm = wave >> 1;
    const int mt = (jl / 14) * 8 + (bid_ & 7), nt = jl % 14, m0 = mt * 256;
    const bool isq = nt < 6;
    __syncthreads();
    {
      const int ncol = isq ? 256 : 128, c0 = isq ? 0 : 256;
      const int sub = tid & 15, rb = tid >> 4;
#pragma unroll 4
      for (int it = 0; it < 16; ++it) {
        const int row = rb + 16 * it;
        const u16* src_ = CQ + (size_t)(m0 + row) * 384 + c0 + sub * 8;
        u32x4 v = *(const u32x4*)src_;
        u32x4 v2 = {0u, 0u, 0u, 0u};
        if (isq) v2 = *(const u32x4*)(src_ + 128);
        const u32 w[8] = {v.x, v.y, v.z, v.w, v2.x, v2.y, v2.z, v2.w};
        float ss = 0.f;
#pragma unroll
        for (int q = 0; q < 8; ++q) { const float a = bflo(w[q]), bb = bfhi(w[q]); ss += a * a + bb * bb; }
        ss += lane_xor(lane, ss, 1); ss += lane_xor(lane, ss, 2); ss += lane_xor(lane, ss, 4); ss += lane_xor(lane, ss, 8);
        if (sub == 0) sR[row] = rsqrtf(ss / (float)ncol + EPS);
      }
    }
    f32x16 acc[2][4];
    zero_acc<4>(acc);
    if (isq) gemm_loop<4>(tid__, acc, (const u16*)(ws + W_UQ) + (size_t)nt * 128 * 256, 256, CQ + (size_t)m0 * 384, 384, 256, sW, sX);
    else gemm_loop<4>(tid__, acc, (const u16*)(ws + W_UKV) + (size_t)(nt - 6) * 128 * 128, 128, CQ + (size_t)m0 * 384 + 256, 384, 128, sW, sX);
    const int s0 = m0 & 4095, b = m0 >> 12;
#pragma unroll
    for (int mi = 0; mi < 4; ++mi) {
      float rs = sR[wm * 128 + mi * 32 + r];
      if (isq) rs *= QS96;
#pragma unroll
      for (int ni = 0; ni < 2; ++ni)
#pragma unroll
        for (int i = 0; i < 16; ++i) acc[ni][mi][i] *= rs;
    }
    if (isq) {
#pragma unroll
      for (int ni = 0; ni < 2; ++ni) {
        const int sj = nt * 4 + wn * 2 + ni;
        if (sj % 3 == 2) {
#pragma unroll
          for (int mi = 0; mi < 4; ++mi) rope_tile(acc[ni][mi], s0 + wm * 128 + mi * 32 + r, h, rt);
        }
      }
    }
    p2_epi<0>(tid__, acc, sC, ws, isq, nt, m0, b, s0);
    p2_epi<1>(tid__, acc, sC, ws, isq, nt, m0, b, s0);
  }
}

template <int DQK, int DV, int MODE>
DI void attn_pass(const int tid__, f32x16 (&O)[DV / 32], float& l_tot, const u16* __restrict__ Qp, int ldq, const u16* __restrict__ Kp, int ldk,
                  const u16* __restrict__ VTp, int kt_lo, int kt_hi, int q0, float m_init, const float* sB, float cL, float cR, u16* sK, u16* sVT) {
  constexpr int KS = DQK / 16, KST = DQK + 8, NKI = DQK / 32, NVI = DV / 32, NV = DV / 32;
  constexpr bool LATEW = (MODE != 2);
  const int tid = tid__, lane = tid & 63, wave = tid >> 6, r = lane & 31, h = lane >> 5;
  const int qrow = wave * 32 + r;
  bf16x8 qf[KS];
  {
    const unsigned qo = (unsigned)(qrow * ldq + h * 8) * 2u;
#pragma unroll
    for (int ks = 0; ks < KS; ++ks) qf[ks] = *(const bf16x8*)((const char*)Qp + qo + ks * 32);
  }
#pragma unroll
  for (int db = 0; db < NV; ++db)
#pragma unroll
    for (int i = 0; i < 16; ++i) O[db][i] = 0.f;
  float m_ref = m_init, l_run = (MODE == 1 && h == 0) ? 1.f : 0.f, cb = 0.f;
  f32x16 cinit;
  const unsigned kgo = (unsigned)((tid >> 2) * ldk + (tid & 3) * 8) * 2u, kso = (unsigned)((tid >> 2) * KST + (tid & 3) * 8) * 2u;
  const unsigned vgo = (unsigned)((tid >> 3) * S + (tid & 7) * 8) * 2u, vso = (unsigned)((tid >> 3) * 72 + (tid & 7) * 8) * 2u;
  const char* kb_ = (const char*)Kp; const char* vb_ = (const char*)VTp;
  constexpr int KBYTES = 64 * KST * 2, VBYTES = DV * 72 * 2;
  u32x4 rk[NKI], rv[NVI];
#pragma unroll
  for (int i = 0; i < NKI; ++i) rk[i] = *(const u32x4*)(kb_ + (size_t)(kt_lo * 64 * ldk) * 2 + i * 64 + kgo);
#pragma unroll
  for (int i = 0; i < NVI; ++i) rv[i] = *(const u32x4*)(vb_ + (size_t)(i * 32 * S + kt_lo * 64) * 2 + vgo);
  const int pr = (r & ~12) | ((r & 4) << 1) | ((r & 8) >> 1);
  const unsigned kfo = (unsigned)(pr * KST + h * 8) * 2u, vfo = (unsigned)(r * 72 + h * 8) * 2u;
  __syncthreads();
#pragma unroll
  for (int i = 0; i < NKI; ++i) *(u32x4*)((char*)sK + kso + i * 64) = rk[i];
#pragma unroll
  for (int i = 0; i < NVI; ++i) *(u32x4*)((char*)sVT + vso + i * (32 * 72 * 2)) = rv[i];
  __syncthreads();
  if (MODE != 1) {
    f32x16 e[2];
#pragma unroll
    for (int kb = 0; kb < 2; ++kb) {
#pragma unroll
      for (int i = 0; i < 16; ++i) e[kb][i] = 0.f;
#pragma unroll
      for (int ks = 0; ks < KS; ++ks) {
        const bf16x8 kf = *(const bf16x8*)((const char*)sK + kfo + kb * (32 * KST * 2) + ks * 32);
        e[kb] = MFMA(kf, qf[ks], e[kb]);
      }
    }
    float mx = e[0][0];
#pragma unroll
    for (int i = 1; i < 16; ++i) mx = fmaxf(mx, e[0][i]);
#pragma unroll
    for (int i = 0; i < 16; ++i) mx = fmaxf(mx, e[1][i]);
    m_ref = xhalf_max(mx);
  }
#pragma unroll
  for (int i = 0; i < 16; ++i) { float t = -m_ref; asm volatile("" : "+v"(t)); cinit[i] = t; }
  int cur = 0;
  for (int kt = kt_lo; kt < kt_hi; ++kt, cur ^= 1) {
    const char* cK = (const char*)sK + cur * KBYTES;
    const char* cV = (const char*)sVT + cur * VBYTES;
    {
      const int ktn = (kt + 1 < kt_hi) ? kt + 1 : kt;
#pragma unroll
      for (int i = 0; i < NKI; ++i) rk[i] = *(const u32x4*)(kb_ + (size_t)(ktn * 64 * ldk) * 2 + i * 64 + kgo);
#pragma unroll
      for (int i = 0; i < NVI; ++i) rv[i] = *(const u32x4*)(vb_ + (size_t)(i * 32 * S + ktn * 64) * 2 + vgo);
    }
    const bool wskip = (MODE == 1) && ((kt * 64 > q0 + (qrow | 31) + 128) || (kt * 64 + 63 < q0 + (qrow & ~31) - 128));
    if (!wskip) {
    bool nearb = (MODE == 1);
    if (MODE == 2) {
      const int k0 = kt * 64;
      float c = 0.f;
      if (k0 - (q0 + 127) >= 91) c = cR; else if (q0 - (k0 + 63) >= 91) c = cL; else nearb = true;
      if (c != cb) {
        cb = c;
#pragma unroll
        for (int i = 0; i < 16; ++i) { float t = cb - m_ref; asm volatile("" : "+v"(t)); cinit[i] = t; }
      }
    }
    f32x16 s[2];
#pragma unroll
    for (int kb = 0; kb < 2; ++kb) {
      const bf16x8 kf0 = *(const bf16x8*)(cK + kfo + kb * (32 * KST * 2));
      s[kb] = MFMA(kf0, qf[0], cinit);
#pragma unroll
      for (int ks = 1; ks < KS; ++ks) {
        const bf16x8 kf = *(const bf16x8*)(cK + kfo + kb * (32 * KST * 2) + ks * 32);
        s[kb] = MFMA(kf, qf[ks], s[kb]);
      }
    }
    if (MODE != 0 && nearb) {
      const float* bp = sB + (kt * 64 + 8 * h - (q0 + qrow) + BTO);
#pragma unroll
      for (int kb = 0; kb < 2; ++kb)
#pragma unroll
        for (int i = 0; i < 16; ++i) s[kb][i] += bp[kb * 32 + (i & 7) + 16 * (i >> 3)];
    }
    float mx = s[0][0];
#pragma unroll
    for (int i = 1; i < 16; ++i) mx = fmaxf(mx, s[0][i]);
#pragma unroll
    for (int i = 0; i < 16; ++i) mx = fmaxf(mx, s[1][i]);
    mx = xhalf_max(mx);
    if (__builtin_expect(__any(mx > 8.f), 0)) {
      const float delta = fmaxf(mx, 0.f);
      const float alpha = fexp2(-delta);
      m_ref += delta;
      l_run *= alpha;
#pragma unroll
      for (int kb = 0; kb < 2; ++kb)
#pragma unroll
        for (int i = 0; i < 16; ++i) s[kb][i] -= delta;
#pragma unroll
      for (int db = 0; db < NV; ++db)
#pragma unroll
        for (int i = 0; i < 16; ++i) O[db][i] *= alpha;
#pragma unroll
      for (int i = 0; i < 16; ++i) { float t = cb - m_ref; asm volatile("" : "+v"(t)); cinit[i] = t; }
    }
    if (!LATEW) {
#pragma unroll
      for (int i = 0; i < NKI; ++i) *(u32x4*)((char*)sK + (cur ^ 1) * KBYTES + kso + i * 64) = rk[i];
#pragma unroll
      for (int i = 0; i < NVI; ++i) *(u32x4*)((char*)sVT + (cur ^ 1) * VBYTES + vso + i * (32 * 72 * 2)) = rv[i];
    }
    float ls = 0.f;
#pragma unroll
    for (int st = 0; st < 4; ++st) {
      const int kb = st >> 1, o = (st & 1) * 8;
      float pe[8];
#pragma unroll
      for (int j = 0; j < 8; ++j) { pe[j] = fexp2(s[kb][o + j]); ls += pe[j]; }
      union { u32 u[4]; bf16x8 v; } pf;
      pf.u[0] = pk2(pe[0], pe[1]); pf.u[1] = pk2(pe[2], pe[3]); pf.u[2] = pk2(pe[4], pe[5]); pf.u[3] = pk2(pe[6], pe[7]);
#pragma unroll
      for (int db = 0; db < NV; ++db) {
        const bf16x8 vf = *(const bf16x8*)(cV + vfo + db * (32 * 72 * 2) + st * 32);
        O[db] = MFMA(vf, pf.v, O[db]);
      }
    }
    l_run += ls;
    }
    if (LATEW) {
#pragma unroll
      for (int i = 0; i < NKI; ++i) *(u32x4*)((char*)sK + (cur ^ 1) * KBYTES + kso + i * 64) = rk[i];
#pragma unroll
      for (int i = 0; i < NVI; ++i) *(u32x4*)((char*)sVT + (cur ^ 1) * VBYTES + vso + i * (32 * 72 * 2)) = rv[i];
    }
    __syncthreads();
  }
  l_tot = xhalf_sum(l_run);
}
template <int DQK, int DV>
DI void attn_pass2(const int tid__, f32x16 (&O)[2][DV / 32], float (&l_tot)[2], const u16* __restrict__ Qp, int ldq, const u16* __restrict__ Kp, int ldk,
                   const u16* __restrict__ VTp, int kt_lo, int kt_hi, u16* sK, u16* sVT) {
  constexpr int KS = DQK / 16, KST = DQK + 8, NKI = DQK / 32, NVI = DV / 32, NV = DV / 32;
  const int tid = tid__, lane = tid & 63, wave = tid >> 6, r = lane & 31, h = lane >> 5;
  bf16x8 qf[2][KS];
#pragma unroll
  for (int qi = 0; qi < 2; ++qi) {
    const unsigned qo = (unsigned)((wave * 64 + qi * 32 + r) * ldq + h * 8) * 2u;
#pragma unroll
    for (int ks = 0; ks < KS; ++ks) qf[qi][ks] = *(const bf16x8*)((const char*)Qp + qo + ks * 32);
  }
#pragma unroll
  for (int qi = 0; qi < 2; ++qi)
#pragma unroll
    for (int db = 0; db < NV; ++db)
#pragma unroll
      for (int i = 0; i < 16; ++i) O[qi][db][i] = 0.f;
  float m_ref[2], l_run[2] = {0.f, 0.f};
  f32x16 cinit[2];
  const unsigned kgo = (unsigned)((tid >> 2) * ldk + (tid & 3) * 8) * 2u, kso = (unsigned)((tid >> 2) * KST + (tid & 3) * 8) * 2u;
  const unsigned vgo = (unsigned)((tid >> 3) * S + (tid & 7) * 8) * 2u, vso = (unsigned)((tid >> 3) * 72 + (tid & 7) * 8) * 2u;
  const char* kb_ = (const char*)Kp; const char* vb_ = (const char*)VTp;
  constexpr int KBYTES = 64 * KST * 2, VBYTES = DV * 72 * 2;
  u32x4 rk[NKI], rv[NVI];
#pragma unroll
  for (int i = 0; i < NKI; ++i) rk[i] = *(const u32x4*)(kb_ + (size_t)(kt_lo * 64 * ldk) * 2 + i * 64 + kgo);
#pragma unroll
  for (int i = 0; i < NVI; ++i) rv[i] = *(const u32x4*)(vb_ + (size_t)(i * 32 * S + kt_lo * 64) * 2 + vgo);
  const int pr = (r & ~12) | ((r & 4) << 1) | ((r & 8) >> 1);
  const unsigned kfo = (unsigned)(pr * KST + h * 8) * 2u, vfo = (unsigned)(r * 72 + h * 8) * 2u;
  __syncthreads();
#pragma unroll
  for (int i = 0; i < NKI; ++i) *(u32x4*)((char*)sK + kso + i * 64) = rk[i];
#pragma unroll
  for (int i = 0; i < NVI; ++i) *(u32x4*)((char*)sVT + vso + i * (32 * 72 * 2)) = rv[i];
  __syncthreads();
#pragma unroll
  for (int qi = 0; qi < 2; ++qi) {
    f32x16 e[2];
#pragma unroll
    for (int kb = 0; kb < 2; ++kb) {
#pragma unroll
      for (int i = 0; i < 16; ++i) e[kb][i] = 0.f;
#pragma unroll
      for (int ks = 0; ks < KS; ++ks) {
        const bf16x8 kf = *(const bf16x8*)((const char*)sK + kfo + kb * (32 * KST * 2) + ks * 32);
        e[kb] = MFMA(kf, qf[qi][ks], e[kb]);
      }
    }
    float mx = e[0][0];
#pragma unroll
    for (int i = 1; i < 16; ++i) mx = fmaxf(mx, e[0][i]);
#pragma unroll
    for (int i = 0; i < 16; ++i) mx = fmaxf(mx, e[1][i]);
    m_ref[qi] = xhalf_max(mx);
#pragma unroll
    for (int i = 0; i < 16; ++i) { float t = -m_ref[qi]; asm volatile("" : "+v"(t)); cinit[qi][i] = t; }
  }
  int cur = 0;
  for (int kt = kt_lo; kt < kt_hi; ++kt, cur ^= 1) {
    const char* cK = (const char*)sK + cur * KBYTES;
    const char* cV = (const char*)sVT + cur * VBYTES;
    {
      const int ktn = (kt + 1 < kt_hi) ? kt + 1 : kt;
#pragma unroll
      for (int i = 0; i < NKI; ++i) rk[i] = *(const u32x4*)(kb_ + (size_t)(ktn * 64 * ldk) * 2 + i * 64 + kgo);
#pragma unroll
      for (int i = 0; i < NVI; ++i) rv[i] = *(const u32x4*)(vb_ + (size_t)(i * 32 * S + ktn * 64) * 2 + vgo);
    }
#pragma unroll
    for (int qi = 0; qi < 2; ++qi) {
      f32x16 s[2];
#pragma unroll
      for (int kb = 0; kb < 2; ++kb) {
        const bf16x8 kf0 = *(const bf16x8*)(cK + kfo + kb * (32 * KST * 2));
        s[kb] = MFMA(kf0, qf[qi][0], cinit[qi]);
#pragma unroll
        for (int ks = 1; ks < KS; ++ks) {
          const bf16x8 kf = *(const bf16x8*)(cK + kfo + kb * (32 * KST * 2) + ks * 32);
          s[kb] = MFMA(kf, qf[qi][ks], s[kb]);
        }
      }
      float mx = s[0][0];
#pragma unroll
      for (int i = 1; i < 16; ++i) mx = fmaxf(mx, s[0][i]);
#pragma unroll
      for (int i = 0; i < 16; ++i) mx = fmaxf(mx, s[1][i]);
      mx = xhalf_max(mx);
      if (__builtin_expect(__any(mx > 8.f), 0)) {
        const float delta = fmaxf(mx, 0.f);
        const float alpha = fexp2(-delta);
        m_ref[qi] += delta;
        l_run[qi] *= alpha;
#pragma unroll
        for (int kb = 0; kb < 2; ++kb)
#pragma unroll
          for (int i = 0; i < 16; ++i) s[kb][i] -= delta;
#pragma unroll
        for (int db = 0; db < NV; ++db)
#pragma unroll
          for (int i = 0; i < 16; ++i) O[qi][db][i] *= alpha;
#pragma unroll
        for (int i = 0; i < 16; ++i) { float t = -m_ref[qi]; asm volatile("" : "+v"(t)); cinit[qi][i] = t; }
      }
      float ls = 0.f;
#pragma unroll
      for (int st = 0; st < 4; ++st) {
        const int kb = st >> 1, o = (st & 1) * 8;
        float pe[8];
#pragma unroll
        for (int j = 0; j < 8; ++j) { pe[j] = fexp2(s[kb][o + j]); ls += pe[j]; }
        union { u32 u[4]; bf16x8 v; } pf;
        pf.u[0] = pk2(pe[0], pe[1]); pf.u[1] = pk2(pe[2], pe[3]); pf.u[2] = pk2(pe[4], pe[5]); pf.u[3] = pk2(pe[6], pe[7]);
#pragma unroll
        for (int db = 0; db < NV; ++db) {
          const bf16x8 vf = *(const bf16x8*)(cV + vfo + db * (32 * 72 * 2) + st * 32);
          O[qi][db] = MFMA(vf, pf.v, O[qi][db]);
        }
      }
      l_run[qi] += ls;
      if (qi == 0) {
#pragma unroll
        for (int i = 0; i < NKI; ++i) *(u32x4*)((char*)sK + (cur ^ 1) * KBYTES + kso + i * 64) = rk[i];
#pragma unroll
        for (int i = 0; i < NVI; ++i) *(u32x4*)((char*)sVT + (cur ^ 1) * VBYTES + vso + i * (32 * 72 * 2)) = rv[i];
      }
    }
    __syncthreads();
  }
#pragma unroll
  for (int qi = 0; qi < 2; ++qi) l_tot[qi] = xhalf_sum(l_run[qi]);
}
template <int NV>
DI void attn_store(const int tid__, const f32x16 (&O)[NV], float rowscale, u16* Zp, int wrows = 32, int roff = 0) {
  const int lane = tid__ & 63, wave = tid__ >> 6, r = lane & 31, h = lane >> 5;
  u16* zr = (u16*)((char*)Zp + (unsigned)((wave * wrows + roff + r) * 1536 + 4 * h) * 2u);
#pragma unroll
  for (int db = 0; db < NV; ++db)
#pragma unroll
    for (int g = 0; g < 4; ++g) {
      const int d = db * 32 + 8 * g;
      const u32x2 z = *(const u32x2*)(zr + d);
      const float c0 = rowscale, c1 = rowscale, c2 = rowscale, c3 = rowscale;
      u32x2 o;
      o.x = pk2(O[db][4 * g] * c0 * bflo(z.x), O[db][4 * g + 1] * c1 * bfhi(z.x));
      o.y = pk2(O[db][4 * g + 2] * c2 * bflo(z.y), O[db][4 * g + 3] * c3 * bfhi(z.y));
      *(u32x2*)(zr + d) = o;
    }
}
constexpr int CTR_WORD0 = 4096;
DI int fetch_job(const int tid_, unsigned* ctr, volatile int* sJ) {
  __syncthreads();
  if (tid_ == 0) *sJ = (int)__hip_atomic_fetch_add(ctr, 1u, __ATOMIC_RELAXED, __HIP_MEMORY_SCOPE_AGENT);
  __syncthreads();
  return *sJ;
}
DI int xcd_remap(int j, int n) { return (j & 7) * (n >> 3) + (j >> 3); }
DI void phase_p3(const int wvu__, const Params& p, int l, unsigned char* smem) {
  const int bid_ = BIDX, gd_ = GDIM;
  unsigned char* ws = p.ws;
  u16* sK = (u16*)smem; u16* sVT = (u16*)(smem + SM_ATT_V);
  float* sB = (float*)(smem + SM_ATT_B);
  const float* BT = (const float*)(ws + OFF_BT);
  u16* Z = (u16*)(ws + A_Z);
  volatile int* sJ = (volatile int*)(smem + 66032);
  unsigned* const ctr0 = (unsigned*)(ws + OFF_BAR) + CTR_WORD0;
  const int qx = bid_ & 7;
#if !defined(P3SEL) || P3SEL == 0
  {
    const float lam = ((const float*)(ws + OFF_LAM))[l];
    for (;;) {
      FRESH_TID(tA, wvu__);
      const int jt = fetch_job(tA, ctr0 + ((l * 3 + 0) * 8 + qx) * 16, sJ);
      if (jt >= 128) break;
      const int job = qx * 128 + jt;
      const int qb = job & 31, hd = (job >> 5) & 3, b = job >> 7;
      const size_t tok0 = (size_t)b * S + qb * 128;
      __syncthreads();
      for (int e = tA; e < BTN; e += 256) sB[e] = BT[(8 + hd) * BTS + e];
      const float cL = BT[(8 + hd) * BTS + 0], cR = BT[(8 + hd) * BTS + BTN - 1];
      const u16* VT = (const u16*)(ws + A_DVT) + (size_t)(b * 512 + hd * 128) * S;
      char* so0 = (char*)(ws + A_O0) + (size_t)bid_ * 32768;
      const unsigned so0l = (unsigned)tA * 128u;
#pragma unroll 1
      for (int c = 0; c < 2; ++c) {
        f32x16 O[4];
        float lt;
        attn_pass<64, 128, 2>(tA, O, lt, (const u16*)(ws + A_DQ) + tok0 * 512 + hd * 128 + c * 64, 512, (const u16*)(ws + A_DK) + (size_t)b * S * 512 + hd * 128 + c * 64, 512,
                              VT, 0, 64, qb * 128, -1e30f, sB, cL, cR, sK, sVT);
        if (c == 0) {
          const float inv = 1.f / lt;
#pragma unroll
          for (int db = 0; db < 4; ++db)
#pragma unroll
            for (int i = 0; i < 8; i += 4) {
              u32x4 v;
              v.x = pk2(O[db][2 * i] * inv, O[db][2 * i + 1] * inv); v.y = pk2(O[db][2 * i + 2] * inv, O[db][2 * i + 3] * inv);
              v.z = pk2(O[db][2 * i + 4] * inv, O[db][2 * i + 5] * inv); v.w = pk2(O[db][2 * i + 6] * inv, O[db][2 * i + 7] * inv);
              *(u32x4*)(so0 + so0l + (db * 8 + i) * 4) = v;
            }
        } else {
          const float inv = lam / lt;
          float ss = 0.f;
          unsigned so0r = so0l; asm volatile("" : "+v"(so0r));
#pragma unroll
          for (int db = 0; db < 4; ++db)
#pragma unroll
            for (int i4 = 0; i4 < 8; i4 += 4) {
              const u32x4 v = *(const u32x4*)(so0 + so0r + (db * 8 + i4) * 4);
              const u32 w[4] = {v.x, v.y, v.z, v.w};
#pragma unroll
              for (int q = 0; q < 4; ++q) {
                const int i = i4 + q;
                const float a = bflo(w[q]) - O[db][2 * i] * inv, cc = bfhi(w[q]) - O[db][2 * i + 1] * inv;
                O[db][2 * i] = a; O[db][2 * i + 1] = cc; ss += a * a + cc * cc;
              }
            }
          ss = xhalf_sum(ss);
          const float rstd = rsqrtf(ss * (1.f / 128.f) + EPS);
          attn_store<4>(tA, O, rstd, Z + tok0 * 1536 + 1024 + hd * 128);
        }
      }
    }
  }
#endif
#if !defined(P3SEL) || P3SEL == 1
  for (;;) {
    FRESH_TID(tB, wvu__);
    const int jt = fetch_job(tB, ctr0 + ((l * 3 + 1) * 8 + qx) * 16, sJ);
    if (jt >= 128) break;
    const int job = qx * 128 + jt;
    const int qb = job & 15, hd = (job >> 4) & 7, b = job >> 7;
    const size_t tok0 = (size_t)b * S + qb * 256;
    f32x16 O[2][2];
    float lt[2];
    attn_pass2<96, 64>(tB, O, lt, (const u16*)(ws + A_MQ) + tok0 * 768 + hd * 96, 768, (const u16*)(ws + A_KM) + (size_t)b * S * 768 + hd * 96, 768,
                       (const u16*)(ws + A_MVT) + (size_t)(b * 512 + hd * 64) * S, 0, 64, sK, sVT);
    attn_store<2>(tB, O[0], 1.f / lt[0], Z + tok0 * 1536 + hd * 64, 64, 0);
    attn_store<2>(tB, O[1], 1.f / lt[1], Z + tok0 * 1536 + hd * 64, 64, 32);
  }
#endif
#if !defined(P3SEL) || P3SEL == 2
  int last_hd_swa = -1;
  for (;;) {
    FRESH_TID(tC, wvu__);
    const int jt = fetch_job(tC, ctr0 + ((l * 3 + 2) * 8 + qx) * 16, sJ);
    if (jt >= 256) break;
    const int job = qx * 256 + jt;
    const int qb = job & 31, hd = (job >> 5) & 7, b = job >> 8, kvh = hd >> 2;
    const size_t tok0 = (size_t)b * S + qb * 128;
    if (hd != last_hd_swa) {
      __syncthreads();
      for (int e = tC; e < BTN; e += 256) sB[e] = BT[hd * BTS + e];
      last_hd_swa = hd;
    }
    const int kt_lo = qb == 0 ? 0 : qb * 2 - 2, kt_hi = qb == 31 ? 64 : qb * 2 + 4;
    f32x16 O[2];
    float lt;
    attn_pass<64, 64, 1>(tC, O, lt, (const u16*)(ws + A_SQ) + tok0 * 512 + hd * 64, 512, (const u16*)(ws + A_SK) + (size_t)b * S * 128 + kvh * 64, 128,
                         (const u16*)(ws + A_SVT) + (size_t)(b * 128 + kvh * 64) * S, kt_lo, kt_hi, qb * 128, PIN(11)[l * 8 + hd] * LOG2E, sB, 0.f, 0.f, sK, sVT);
    attn_store<2>(tC, O, 1.f / lt, Z + tok0 * 1536 + 512 + hd * 64);
  }
#endif
}

DI void phase_p4(const int wvu__, const Params& p, unsigned char* smem) {
  FRESH_TID(tid__, wvu__);
  const int bid_ = BIDX, gd_ = GDIM;
  unsigned char* ws = p.ws;
  u16* sW = (u16*)smem; u16* sX = (u16*)(smem + 18432); u16* sC = (u16*)smem;
  const u16* WG = (const u16*)(ws + W_G); const u16* WO = (const u16*)(ws + W_O);
  const u16* H = (const u16*)(ws + A_H); const u16* Zs = (const u16*)(ws + A_Z);
  const int jstep = gd_ >> 3;
  GStage<2> st;
  {
    const int jl = bid_ >> 3;
    if (jl < 32 * 8) {
      const int mt = (jl >> 3) * 8 + (bid_ & 7), nt = jl & 7;
      gemm_prefetch<2>(tid__, st, WG + (size_t)(nt * 128) * 1024, 1024, H + (size_t)(mt * 128) * 1024, 1024);
    }
  }
  for (int jl = bid_ >> 3; jl < 32 * 8; jl += jstep) {
    const int mt = (jl >> 3) * 8 + (bid_ & 7), nt = jl & 7, m0 = mt * 128, n0 = nt * 128;
    const int jn = (jl + jstep < 32 * 8) ? jl + jstep : jl;
    const int m0n = ((jn >> 3) * 8 + (bid_ & 7)) * 128, n0n = (jn & 7) * 128;
    f32x16 macc[2][2];
    zero_acc<2>(macc);
#pragma unroll 1
    for (int j = 0; j < 3; ++j) {
      f32x16 acc[2][2];
      zero_acc<2>(acc);
      const u16* wg = WG + (size_t)(j * 1024 + n0) * 1024; const u16* xg = H + (size_t)m0 * 1024;
      const u16* wo = WO + (size_t)j * 1024 * 512 + (size_t)n0 * 512; const u16* xo = Zs + (size_t)m0 * 1536 + j * 512;
      gemm_loop_chain<2>(tid__, acc, st, wg, 1024, xg, 1024, 1024, sW, sX, wo, 512, xo, 1536);
      char* sg = (char*)(ws + A_O0) + (size_t)bid_ * 32768;
      const unsigned sgl = (unsigned)tid__ * 128u;
#pragma unroll
      for (int a = 0; a < 2; ++a)
#pragma unroll
        for (int b = 0; b < 2; ++b)
#pragma unroll
          for (int i = 0; i < 8; i += 4) {
            u32x4 v;
            v.x = pk2(sigmoidf_(acc[a][b][2 * i]), sigmoidf_(acc[a][b][2 * i + 1])); v.y = pk2(sigmoidf_(acc[a][b][2 * i + 2]), sigmoidf_(acc[a][b][2 * i + 3]));
            v.z = pk2(sigmoidf_(acc[a][b][2 * i + 4]), sigmoidf_(acc[a][b][2 * i + 5])); v.w = pk2(sigmoidf_(acc[a][b][2 * i + 6]), sigmoidf_(acc[a][b][2 * i + 7]));
            *(u32x4*)(sg + sgl + ((a * 2 + b) * 8 + i) * 4) = v;
          }
      zero_acc<2>(acc);
      unsigned sgr = sgl; asm volatile("" : "+v"(sgr));
      const u16* wnx = (j < 2) ? WG + (size_t)((j + 1) * 1024 + n0) * 1024 : WG + (size_t)n0n * 1024;
      const u16* xnx = (j < 2) ? xg : H + (size_t)m0n * 1024;
      gemm_loop_chain<2>(tid__, acc, st, wo, 512, xo, 1536, 512, sW, sX, wnx, 1024, xnx, 1024);
#pragma unroll
      for (int a = 0; a < 2; ++a)
#pragma unroll
        for (int b = 0; b < 2; ++b)
#pragma unroll
          for (int i4 = 0; i4 < 8; i4 += 4) {
            const u32x4 v = *(const u32x4*)(sg + sgr + ((a * 2 + b) * 8 + i4) * 4);
            const u32 w[4] = {v.x, v.y, v.z, v.w};
#pragma unroll
            for (int q = 0; q < 4; ++q) {
              const int i = i4 + q;
              macc[a][b][2 * i] += bflo(w[q]) * acc[a][b][2 * i];
              macc[a][b][2 * i + 1] += bfhi(w[q]) * acc[a][b][2 * i + 1];
            }
          }
    }
    __syncthreads();
    stage_normal<2>(tid__, macc, sC); __syncthreads();
    store_rows(tid__, sC, (u16*)(ws + A_M) + (size_t)m0 * 1024 + n0, 1024, ColId());
  }
}
DI void phase_p5(const int wvu__, const Params& p, unsigned char* smem) {
  FRESH_TID(tid__, wvu__);
  const int bid_ = BIDX, gd_ = GDIM;
  unsigned char* ws = p.ws;
  u16* sW = (u16*)smem; u16* sX = (u16*)(smem + 18432); u16* sC = (u16*)smem;
  for (int jl = bid_ >> 3; jl < 16 * 8; jl += gd_ >> 3) {
    const int mt = (jl >> 3) * 8 + (bid_ & 7), nt = jl & 7, m0 = mt * 256, n0 = nt * 128;
    f32x16 acc[2][4];
    zero_acc<4>(acc);
    gemm_loop<4>(tid__, acc, (const u16*)(ws + W_OUT) + (size_t)n0 * 1024, 1024, (const u16*)(ws + A_M) + (size_t)m0 * 1024, 1024, 1024, sW, sX);
    __syncthreads();
    stage_normal<4, 0>(tid__, acc, sC); __syncthreads();
    store_rows(tid__, sC, (u16*)(ws + A_Y) + (size_t)m0 * 1024 + n0, 1024, ColId(), 64);
    __syncthreads();
    stage_normal<4, 1>(tid__, acc, sC); __syncthreads();
    store_rows(tid__, sC, (u16*)(ws + A_Y) + (size_t)(m0 + 64) * 1024 + n0, 1024, ColId(), 64);
  }
}


#define XB_TMO      128
#define XB_XCNT(j)  (256  + 64 * (j))
#define XB_XSUB(j)  (1280 + 64 * (j))
#define XB_XGEN(j)  (2304 + 64 * (j))
#define XB_TOP      3328
#define XB_TOPGEN   3392
#define XCD_BAR_WORDS 3456
#define XB_SPIN_CAP (1u << 18)
#define LAS __attribute__((address_space(3)))
DI unsigned xb_ld(unsigned* p)              { return __hip_atomic_load(p, __ATOMIC_RELAXED, __HIP_MEMORY_SCOPE_AGENT); }
DI unsigned xb_add(unsigned* p, unsigned v) { return __hip_atomic_fetch_add(p, v, __ATOMIC_RELAXED, __HIP_MEMORY_SCOPE_AGENT); }
DI unsigned xb_xcc_id() { return (unsigned)__builtin_amdgcn_s_getreg((3 << 11) | 20) & 0xFu; }
#define XB_SPIN(cond, bar) do { unsigned _sp = 0; while (cond) { __builtin_amdgcn_s_sleep(1); \
    if ((++_sp & 255u) == 0u) { if (xb_ld(&(bar)[XB_TMO])) break; if (_sp > XB_SPIN_CAP) { atomicAdd(&(bar)[XB_TMO], 1u); break; } } } } while (0)
struct XcdBarrier { unsigned* bar; unsigned x; volatile LAS unsigned* st; };
DI XcdBarrier xcd_barrier_post(const int tid_, unsigned* bar, volatile LAS unsigned* st) {
  XcdBarrier b; b.bar = bar; b.x = xb_xcc_id(); b.st = st;
  if (tid_ == 0) (void)xb_add(&bar[XB_XCNT(b.x)], 1u);
  return b;
}
DI void xcd_barrier_complete(unsigned* bar, unsigned x, unsigned& nloc, unsigned& nx) {
  const unsigned G = gridDim.x * gridDim.y * gridDim.z;
  unsigned sum, cnt, mine, sp = 0u;
  for (;;) {
    sum = 0u; cnt = 0u; mine = 0u;
#pragma unroll
    for (unsigned j = 0; j < 16; ++j) { const unsigned c = xb_ld(&bar[XB_XCNT(j)]); sum += c; cnt += (c > 0u) ? 1u : 0u; mine = (j == x) ? c : mine; }
    if (sum == G) break;
    __builtin_amdgcn_s_sleep(1);
    if ((++sp & 255u) == 0u) { if (xb_ld(&bar[XB_TMO])) break; if (sp > XB_SPIN_CAP) { atomicAdd(&bar[XB_TMO], 1u); break; } }
  }
  nloc = mine > 0u ? mine : 1u; nx = cnt > 0u ? cnt : 1u;
}
DI void xcd_barrier(const int tid_, const XcdBarrier& b) {
  asm volatile("s_waitcnt vmcnt(0)" ::: "memory");
  __syncthreads();
  if (tid_ == 0) {
    unsigned* bar = b.bar;
    __builtin_amdgcn_s_waitcnt(0);
    unsigned nloc = b.st[0], nx = b.st[1];
    if (nloc == 0u) { xcd_barrier_complete(bar, b.x, nloc, nx); b.st[0] = nloc; b.st[1] = nx; }
    const unsigned old = xb_add(&bar[XB_XSUB(b.x)], 1u);
    const unsigned gen = old / nloc;
    if (old + 1u == (gen + 1u) * nloc) {
      __builtin_amdgcn_fence(__ATOMIC_RELEASE, "agent");
      asm volatile("s_waitcnt vmcnt(0)" ::: "memory");
      const unsigned og = xb_add(&bar[XB_TOP], 1u);
      const unsigned tg = og / nx;
      if (og + 1u == (tg + 1u) * nx) xb_add(&bar[XB_TOPGEN], 1u);
      else XB_SPIN(xb_ld(&bar[XB_TOPGEN]) == tg, bar);
      __builtin_amdgcn_fence(__ATOMIC_ACQUIRE, "agent");
      xb_add(&bar[XB_XGEN(b.x)], 1u);
      asm volatile("s_waitcnt vmcnt(0)" ::: "memory");
    } else {
      XB_SPIN(xb_ld(&bar[XB_XGEN(b.x)]) == gen, bar);
      __builtin_amdgcn_fence(__ATOMIC_ACQUIRE, "agent");
      asm volatile("s_waitcnt vmcnt(0)" ::: "memory");
    }
  }
  __syncthreads();
}

__global__ void __launch_bounds__(256, 2) mega(Params p) {
  __shared__ __attribute__((aligned(16))) unsigned char smem[SMEM_BYTES];
  __shared__ uint4 xb_words;
  const int wave_u = __builtin_amdgcn_readfirstlane((int)threadIdx.x >> 6);
  const int tid_s = (wave_u << 6) | (int)__builtin_amdgcn_mbcnt_hi(~0u, __builtin_amdgcn_mbcnt_lo(~0u, 0u));
  if (tid_s == 0) xb_words = make_uint4(0u, 0u, 0u, 0u);
  __syncthreads();
  const XcdBarrier xb = xcd_barrier_post(tid_s, (unsigned*)(p.ws + OFF_BAR), (volatile LAS unsigned*)&xb_words);
  for (int ph = p.ph_lo; ph < p.ph_hi; ++ph) {
#ifdef ONLY
    { const int l = (ph - 2) / PPL;
      if (ONLY == 0) phase0(wave_u, p, smem);
      if (ONLY == 1) phase_p1(wave_u, p, smem);
      if (ONLY == 2) phase_p2(wave_u, p, smem);
      if (ONLY == 3) phase_p3(wave_u, p, l, smem);
      if (ONLY == 4) phase_p4(wave_u, p, smem);
      if (ONLY == 5) phase_p5(wave_u, p, smem);
      if (ONLY == 6) phase_norm(wave_u, p, l, smem); }
#else
    if (ph == 0) phase0(wave_u, p, smem);
    else if (ph == 1) phase_norm(wave_u, p, -1, smem);
    else {
      const int l = (ph - 2) / PPL, sq = (ph - 2) % PPL;
      const int sp = (int)((PSEQ >> (4 * sq)) & 15);
      if (sp == 0) phase_p1(wave_u, p, smem);
      else if (sp == 1) phase_p2(wave_u, p, smem);
      else if (sp == 2) phase_p3(wave_u, p, l, smem);
      else if (sp == 3) phase_p4(wave_u, p, smem);
      else if (sp == 4) phase_p5(wave_u, p, smem);
      else phase_norm(wave_u, p, l, smem);
    }
#endif
    if (ph + 1 < p.ph_hi) {
      if (p.ph_hi > 4096) cg::this_grid().sync();
      else { FRESH_TID(tbar, wave_u); xcd_barrier(tbar, xb); }
    }
  }
}

extern "C" void kernel_launch(void* const* d_in, const int* in_sizes, int n_in, void* d_out, int out_size, void* d_ws, size_t ws_size, hipStream_t stream) {
  static int grid = 0;
  if (grid == 0) {
    if (n_in != 22 || out_size != T * D || ws_size < WS_END) {
      fprintf(stderr, "kernel_launch: unexpected sizes n_in %d out %d ws %zu (need %zu)\n", n_in, out_size, ws_size, (size_t)WS_END);
      grid = -1; return;
    }
    int dev = 0, cus = 0, per_cu = 0;
    hipGetDevice(&dev);
    hipDeviceGetAttribute(&cus, hipDeviceAttributeMultiprocessorCount, dev);
    hipOccupancyMaxActiveBlocksPerMultiprocessor(&per_cu, (const void*)mega, 256, 0);
    if (per_cu < 1) per_cu = 1;
    if (per_cu > 2) per_cu = 2;
    grid = (cus * per_cu) & ~7;
    fprintf(stderr, "kernel_launch: grid %d (%d CUs x %d)\n", grid, cus, per_cu);
  }
  if (grid < 0) return;
  Params p{};
  for (int i = 0; i < 22; ++i) p.in[i] = (const float*)d_in[i];
  p.out = (float*)d_out;
  p.ws = (unsigned char*)d_ws;
  for (int i = 0; i < 16; ++i) p.inv_freq[i] = (float)pow(10000.0, -(double)i / 16.0);
  for (int l = 0; l < 4; ++l) p.lam_init[l] = (float)(0.8 - 0.6 * exp(-0.3 * l));
#if SINGLE_LAUNCH
  if (hipMemsetAsync((char*)d_ws + OFF_BAR, 0, 24576, stream) != hipSuccess) { fprintf(stderr, "kernel_launch: memset of the barrier words failed\n"); return; }
  p.ph_lo = 0; p.ph_hi = NPHASE;
  void* args[] = {&p};
  hipError_t e = hipLaunchCooperativeKernel((const void*)mega, dim3(grid), dim3(256), args, 0, stream);
  if (e != hipSuccess) fprintf(stderr, "cooperative launch failed: %s (grid %d)\n", hipGetErrorString(e), grid);
#else
  for (int ph = 0; ph < NPHASE; ++ph) {
    p.ph_lo = ph; p.ph_hi = ph + 1;
    hipLaunchKernelGGL(mega, dim3(grid), dim3(256), 0, stream, p);
  }
#endif
}
```

```cpp
#include <hip/hip_runtime.h>
#include <hip/hip_cooperative_groups.h>
#include <cstdio>
#include <cstdint>
#include <cmath>
namespace cg = cooperative_groups;

#ifndef SINGLE_LAUNCH
#define SINGLE_LAUNCH 1
#endif

typedef unsigned short u16;
typedef unsigned int u32;
typedef short bf16x8 __attribute__((ext_vector_type(8)));
typedef float f32x16 __attribute__((ext_vector_type(16)));
typedef unsigned int u32x4 __attribute__((ext_vector_type(4)));
typedef unsigned int u32x2 __attribute__((ext_vector_type(2)));
#define DI __device__ __forceinline__
#define MFMA(a, b, c) __builtin_amdgcn_mfma_f32_32x32x16_bf16((a), (b), (c), 0, 0, 0)

constexpr int D = 1024, NB = 8, S = 4096, T = NB * S, DEPTH = 4, INC = 7328;
constexpr float LOG2E = 1.4426950408889634f;
constexpr float EPS = 1e-6f;
#ifdef PROBE_GEMM2
constexpr int PPL = 10; constexpr unsigned long long PSEQ = 0x5443321100ull;
#else
constexpr int PPL = 6; constexpr unsigned long long PSEQ = 0x543210ull;
#endif
constexpr int NPHASE = 2 + PPL * DEPTH;

constexpr size_t MiB = 1048576;
constexpr size_t OFF_MOD = 256;
constexpr size_t OFF_ROPE = OFF_MOD + 393216;
constexpr size_t OFF_BT = OFF_ROPE + 524288;
constexpr size_t OFF_LAM = OFF_BT + 28672;
constexpr int BTS = 584, BTN = 577, BTO = 288;
constexpr size_t OFF_BAR = 983040;
constexpr size_t OFF_W = 1 * MiB;
constexpr size_t W_P1 = OFF_W;
constexpr size_t W_G = W_P1 + 4352ull * 1024 * 2;
constexpr size_t W_UQ = W_G + 3072ull * 1024 * 2;
constexpr size_t W_UKV = W_UQ + 768ull * 256 * 2;
constexpr size_t W_O = W_UKV + 1024ull * 128 * 2;
constexpr size_t W_OUT = W_O + 3ull * 1024 * 512 * 2;
constexpr size_t OFF_ACT = 23 * MiB;
constexpr size_t A_H = OFF_ACT;
constexpr size_t A_CQ = A_H + 64 * MiB;
constexpr size_t A_Z = A_CQ + 24 * MiB;
constexpr size_t A_SQ = A_Z + 96 * MiB;
constexpr size_t A_SK = A_SQ + 32 * MiB;
constexpr size_t A_SVT = A_SK + 8 * MiB;
constexpr size_t A_DQ = A_SVT + 8 * MiB;
constexpr size_t A_DK = A_DQ + 32 * MiB;
constexpr size_t A_DVT = A_DK + 32 * MiB;
constexpr size_t A_MQ = A_DVT + 32 * MiB;
constexpr size_t A_KM = A_MQ + 48 * MiB;
constexpr size_t A_MVT = A_KM + 48 * MiB;
constexpr size_t A_O0 = A_MVT + 32 * MiB;
constexpr size_t WS_END = A_O0 + 32 * MiB;
constexpr size_t A_M = A_DQ;
constexpr size_t A_Y = A_MQ;
static_assert(W_OUT + 1024ull * 1024 * 2 <= OFF_ACT, "weights overflow");

struct Params {
  const float* in[22];
  float* out;
  unsigned char* ws;
  float inv_freq[16];
  float lam_init[4];
  int ph_lo, ph_hi;
};

#ifndef SKEW_ATT
#define SKEW_ATT 12
#endif
constexpr int SMEM_BYTES = 66048;
constexpr int SM_AUX = 36864;
constexpr int SM_ATT_V = 26624;
constexpr int SM_ATT_B = 63488;

typedef float f32x2_ __attribute__((ext_vector_type(2)));
typedef __bf16 bf16x2_ __attribute__((ext_vector_type(2)));
DI u32 pk2(float lo, float hi) { f32x2_ v = {lo, hi}; bf16x2_ r = __builtin_convertvector(v, bf16x2_); return __builtin_bit_cast(u32, r); }
DI u16 f2bf(float x) { return (u16)(pk2(x, 0.f) & 0xffffu); }
DI float bflo(u32 v) { return __uint_as_float(v << 16); }
DI float bfhi(u32 v) { return __uint_as_float(v & 0xffff0000u); }
DI unsigned char* launder_ptr(const void* q) {
  unsigned long long v = (unsigned long long)q;
  u32 lo = (u32)v, hi = (u32)(v >> 32);
  asm volatile("" : "+v"(lo), "+v"(hi));
  lo = __builtin_amdgcn_readfirstlane(lo); hi = __builtin_amdgcn_readfirstlane(hi);
  return (unsigned char*)(((unsigned long long)hi << 32) | lo);
}
struct Params;
DI int opaque_uniform(int i) { asm volatile("" : "+v"(i)); return __builtin_amdgcn_readfirstlane(i); }
#define PIN(k) (p.in[opaque_uniform(k)])
#define FRESH_TID(v, wv) unsigned v##z = 0u; asm volatile("" : "+v"(v##z)); const int v = ((wv) << 6) | (int)__builtin_amdgcn_mbcnt_hi(~0u, __builtin_amdgcn_mbcnt_lo(~0u, v##z))
#define BIDX opaque_uniform((int)blockIdx.x)
#define GDIM opaque_uniform((int)gridDim.x)
DI float fexp2(float x) { return __builtin_amdgcn_exp2f(x); }
DI float frcp(float x) { return __builtin_amdgcn_rcpf(x); }
DI float sigmoidf_(float x) { return frcp(1.f + fexp2(-x * LOG2E)); }
DI float siluf_(float x) { return x * sigmoidf_(x); }
DI int crow(int i, int h) { return (i & 3) + 8 * (i >> 2) + 4 * h; }
DI float lane_xor(int lane, float v, int m) { return __int_as_float(__builtin_amdgcn_ds_bpermute((lane ^ m) << 2, __float_as_int(v))); }
DI float wave_sum(int lane, float v) {
#pragma unroll
  for (int m = 32; m >= 1; m >>= 1) v += lane_xor(lane, v, m);
  return v;
}
DI float xhalf_max(float v) { auto rr = __builtin_amdgcn_permlane32_swap(__float_as_uint(v), __float_as_uint(v), false, false); return fmaxf(__uint_as_float(rr[0]), __uint_as_float(rr[1])); }
DI float xhalf_sum(float v) { auto rr = __builtin_amdgcn_permlane32_swap(__float_as_uint(v), __float_as_uint(v), false, false); return __uint_as_float(rr[0]) + __uint_as_float(rr[1]); }

template <int MT>
DI void gemm_loop(const int tid__, f32x16 (&acc)[2][MT], const u16* __restrict__ Wp, int ldw, const u16* __restrict__ Xp, int ldx, int K, u16* sW, u16* sX) {
  const int tid = tid__, lane = tid & 63, wave = tid >> 6;
  const int r = lane & 31, h = lane >> 5, wn = wave & 1, wm = wave >> 1;
  const int lrow = tid >> 3, lch = tid & 7;
  const unsigned wo = (unsigned)(lrow * ldw + lch * 8) * 2u, xo = (unsigned)(lrow * ldx + lch * 8) * 2u;
  const unsigned so = (unsigned)(lrow * 72 + lch * 8) * 2u;
  const char* wb = (const char*)Wp; const char* xb = (const char*)Xp;
  u32x4 rw[4], rx[2 * MT];
#pragma unroll
  for (int i = 0; i < 4; ++i) rw[i] = *(const u32x4*)(wb + (size_t)(32 * i * ldw) * 2 + wo);
#pragma unroll
  for (int i = 0; i < 2 * MT; ++i) rx[i] = *(const u32x4*)(xb + (size_t)(32 * i * ldx) * 2 + xo);
  const int nkt = K >> 6;
  const unsigned fa = (unsigned)((wn * 64 + r) * 72 + h * 8) * 2u, fb = (unsigned)((wm * 32 * MT + r) * 72 + h * 8) * 2u;
  for (int kt = 0; kt < nkt; ++kt) {
    __syncthreads();
#pragma unroll
    for (int i = 0; i < 4; ++i) *(u32x4*)((char*)sW + so + i * (32 * 72 * 2)) = rw[i];
#pragma unroll
    for (int i = 0; i < 2 * MT; ++i) *(u32x4*)((char*)sX + so + i * (32 * 72 * 2)) = rx[i];
    __syncthreads();
    {
      const int k0 = (kt + 1 < nkt ? kt + 1 : kt) * 64;
#pragma unroll
      for (int i = 0; i < 4; ++i) rw[i] = *(const u32x4*)(wb + (size_t)(32 * i * ldw + k0) * 2 + wo);
#pragma unroll
      for (int i = 0; i < 2 * MT; ++i) rx[i] = *(const u32x4*)(xb + (size_t)(32 * i * ldx + k0) * 2 + xo);
    }
    __builtin_amdgcn_sched_barrier(0);
#pragma unroll
    for (int ks = 0; ks < 4; ++ks) {
      bf16x8 a[2], b[MT];
#pragma unroll
      for (int q = 0; q < 2; ++q) a[q] = *(const bf16x8*)((const char*)sW + fa + q * (32 * 72 * 2) + ks * 32);
#pragma unroll
      for (int q = 0; q < MT; ++q) b[q] = *(const bf16x8*)((const char*)sX + fb + q * (32 * 72 * 2) + ks * 32);
#pragma unroll
      for (int ni = 0; ni < 2; ++ni)
#pragma unroll
        for (int mi = 0; mi < MT; ++mi) acc[ni][mi] = MFMA(a[ni], b[mi], acc[ni][mi]);
    }
  }
}
template <int MT> struct GStage { u32x4 rw[4]; u32x4 rx[2 * MT]; };
template <int MT>
DI void gemm_prefetch(const int tid__, GStage<MT>& st, const u16* __restrict__ Wp, int ldw, const u16* __restrict__ Xp, int ldx) {
  const int lrow = tid__ >> 3, lch = tid__ & 7;
  const unsigned wo = (unsigned)(lrow * ldw + lch * 8) * 2u, xo = (unsigned)(lrow * ldx + lch * 8) * 2u;
#pragma unroll
  for (int i = 0; i < 4; ++i) st.rw[i] = *(const u32x4*)((const char*)Wp + (size_t)(32 * i * ldw) * 2 + wo);
#pragma unroll
  for (int i = 0; i < 2 * MT; ++i) st.rx[i] = *(const u32x4*)((const char*)Xp + (size_t)(32 * i * ldx) * 2 + xo);
}
template <int MT>
DI void gemm_loop_chain(const int tid__, f32x16 (&acc)[2][MT], GStage<MT>& st, const u16* __restrict__ Wp, int ldw, const u16* __restrict__ Xp, int ldx, int K, u16* sW, u16* sX,
                        const u16* __restrict__ Wn, int ldwn, const u16* __restrict__ Xn, int ldxn) {
  const int tid = tid__, lane = tid & 63, wave = tid >> 6;
  const int r = lane & 31, h = lane >> 5, wn = wave & 1, wm = wave >> 1;
  const int lrow = tid >> 3, lch = tid & 7;
  const unsigned so = (unsigned)(lrow * 72 + lch * 8) * 2u;
  const int nkt = K >> 6;
  const unsigned fa = (unsigned)((wn * 64 + r) * 72 + h * 8) * 2u, fb = (unsigned)((wm * 32 * MT + r) * 72 + h * 8) * 2u;
  for (int kt = 0; kt < nkt; ++kt) {
    __syncthreads();
#pragma unroll
    for (int i = 0; i < 4; ++i) *(u32x4*)((char*)sW + so + i * (32 * 72 * 2)) = st.rw[i];
#pragma unroll
    for (int i = 0; i < 2 * MT; ++i) *(u32x4*)((char*)sX + so + i * (32 * 72 * 2)) = st.rx[i];
    __syncthreads();
    {
      const bool last = kt + 1 >= nkt;
      const char* wb = last ? (const char*)Wn : (const char*)Wp + (size_t)(kt + 1) * 128;
      const char* xb = last ? (const char*)Xn : (const char*)Xp + (size_t)(kt + 1) * 128;
      const int lw = last ? ldwn : ldw, lx = last ? ldxn : ldx;
      const unsigned wo = (unsigned)(lrow * lw + lch * 8) * 2u, xo = (unsigned)(lrow * lx + lch * 8) * 2u;
#pragma unroll
      for (int i = 0; i < 4; ++i) st.rw[i] = *(const u32x4*)(wb + (size_t)(32 * i * lw) * 2 + wo);
#pragma unroll
      for (int i = 0; i < 2 * MT; ++i) st.rx[i] = *(const u32x4*)(xb + (size_t)(32 * i * lx) * 2 + xo);
    }
    __builtin_amdgcn_sched_barrier(0);
#pragma unroll
    for (int ks = 0; ks < 4; ++ks) {
      bf16x8 a[2], b[MT];
#pragma unroll
      for (int q = 0; q < 2; ++q) a[q] = *(const bf16x8*)((const char*)sW + fa + q * (32 * 72 * 2) + ks * 32);
#pragma unroll
      for (int q = 0; q < MT; ++q) b[q] = *(const bf16x8*)((const char*)sX + fb + q * (32 * 72 * 2) + ks * 32);
#pragma unroll
      for (int ni = 0; ni < 2; ++ni)
#pragma unroll
        for (int mi = 0; mi < MT; ++mi) acc[ni][mi] = MFMA(a[ni], b[mi], acc[ni][mi]);
    }
  }
}
template <int MT> DI void zero_acc(f32x16 (&acc)[2][MT]) {
#pragma unroll
  for (int a = 0; a < 2; ++a)
#pragma unroll
    for (int b = 0; b < MT; ++b)
#pragma unroll
      for (int i = 0; i < 16; ++i) acc[a][b][i] = 0.f;
}
struct FId { DI float operator()(float x) const { return x; } };
struct FSilu { DI float operator()(float x) const { return siluf_(x); } };
struct FScale { float s; DI float operator()(float x) const { return x * s; } };
template <int MT, int E = 0, class F = FId> DI void stage_normal(const int tid__, const f32x16 (&acc)[2][MT], u16* sC, F f = F()) {
  const int lane = tid__ & 63, wave = tid__ >> 6, r = lane & 31, h = lane >> 5, wn = wave & 1, wm = wave >> 1;
#pragma unroll
  for (int ni = 0; ni < 2; ++ni)
#pragma unroll
    for (int mj = 0; mj < 2; ++mj)
#pragma unroll
      for (int g = 0; g < 4; ++g) {
        const int n = wn * 64 + ni * 32 + 8 * g + 4 * h, tok = wm * 64 + mj * 32 + r;
        u32x2 v;
        constexpr int MB = (MT == 2 || E == 0) ? 0 : MT - 2;
        v.x = pk2(f(acc[ni][MB + mj][4 * g]), f(acc[ni][MB + mj][4 * g + 1])); v.y = pk2(f(acc[ni][MB + mj][4 * g + 2]), f(acc[ni][MB + mj][4 * g + 3]));
        *(u32x2*)(sC + tok * 136 + n) = v;
      }
}
template <int MT, int E = 0> DI void stage_transposed(const int tid__, const f32x16 (&acc)[2][MT], u16* sCt) {
  const int lane = tid__ & 63, wave = tid__ >> 6, r = lane & 31, h = lane >> 5, wn = wave & 1, wm = wave >> 1;
#pragma unroll
  for (int ni = 0; ni < 2; ++ni)
#pragma unroll
    for (int mj = 0; mj < 2; ++mj)
#pragma unroll
      for (int i = 0; i < 16; ++i) {
        const int n = wn * 64 + ni * 32 + crow(i, h), tok = wm * 64 + mj * 32 + r;
        constexpr int MB = (MT == 2 || E == 0) ? 0 : MT - 2;
        const float v = acc[ni][MB + mj][i];
        sCt[n * 136 + tok] = f2bf(v);
      }
}
template <class F> DI void store_rows(const int tid__, const u16* sC, u16* dst, int ld, F colfn, int rs = 0) {
  const int tid = tid__, ch = tid & 15, r0 = tid >> 4;
  const unsigned lo = (unsigned)(r0 * ld + colfn(ch * 8)) * 2u;
#pragma unroll
  for (int it = 0; it < 8; ++it) {
    const u32x4 v = *(const u32x4*)((const char*)sC + (unsigned)((r0 * 136 + ch * 8) * 2) + it * (16 * 136 * 2));
    *(u32x4*)((char*)dst + (size_t)((16 * it + (it >> 2) * rs) * ld) * 2 + lo) = v;
  }
}
struct ColId { DI int operator()(int c) const { return c; } };
struct ColTok { DI int operator()(int c) const { return (c >> 6) * 128 + (c & 63); } };

DI void conv_tile(const int tid__, const float* __restrict__ src, int ld, int srccol, int k0, const float* __restrict__ kscale, u16* __restrict__ dst, int K, int n0, u16* sm, int kmask = 0x7fffffff, float kmul = 1.f) {
  const int tid = tid__, col = tid & 31, rw = tid >> 5;
  __syncthreads();
  float vv[16];
#pragma unroll
  for (int i = 0; i < 16; ++i) {
    const int k = rw + 8 * i;
    vv[i] = 0.f;
    if (srccol >= 0) { vv[i] = src[(size_t)(k0 + k) * ld + srccol + col]; if (kscale) vv[i] *= kscale[(k0 + k) & kmask] * kmul; }
  }
#pragma unroll
  for (int i = 0; i < 16; ++i) sm[col * 136 + rw + 8 * i] = f2bf(vv[i]);
  __syncthreads();
  const int n = tid >> 3, ch = tid & 7;
#pragma unroll
  for (int it = 0; it < 2; ++it) {
    const int c = ch + 8 * it;
    const u32x4 v = *(const u32x4*)(sm + n * 136 + c * 8);
    *(u32x4*)(dst + (size_t)(n0 + n) * K + k0 + c * 8) = v;
  }
}
constexpr int CONV_JOBS = 1088 + 768 + 48 + 32 + 384 + 256;
DI void conv_job(const int tid__, const Params& p, int l, int jid, u16* sm) {
  unsigned char* ws = p.ws;
  if (jid < 1088) {
    const int tj = jid >> 3, kt = jid & 7;
    const int sc = tj < 13 ? 32 * tj : (tj < 16 ? -1 : 32 * (tj - 3));
    conv_tile(tid__, PIN(6) + (size_t)l * D * INC, INC, sc, kt * 128, nullptr, (u16*)(ws + W_P1), 1024, tj * 32, sm);
    return;
  }
  jid -= 1088;
  if (jid < 768) {
    const int tj = jid >> 3, kt = jid & 7;
    conv_tile(tid__, PIN(6) + (size_t)l * D * INC, INC, 4256 + 32 * tj, kt * 128, nullptr, (u16*)(ws + W_G), 1024, tj * 32, sm);
    return;
  }
  jid -= 768;
  if (jid < 48) {
    const int tj = jid >> 1, kt = jid & 1;
    conv_tile(tid__, PIN(8) + (size_t)l * 256 * 768, 768, 32 * tj, kt * 128, PIN(7) + l * 256, (u16*)(ws + W_UQ), 256, tj * 32, sm);
    return;
  }
  jid -= 48;
  if (jid < 32) {
    const int tj = jid;
    const int sc = tj < 16 ? (tj >> 1) * 128 + (tj & 1) * 32 : ((tj - 16) >> 1) * 128 + 64 + ((tj - 16) & 1) * 32;
    conv_tile(tid__, PIN(10) + (size_t)l * 128 * 1024, 1024, sc, 0, PIN(9) + l * 128, (u16*)(ws + W_UKV), 128, tj * 32, sm);
    return;
  }
  jid -= 32;
  if (jid < 384) {
    const int which = jid >> 7, jj = jid & 127, tj = jj >> 2, kt = jj & 3;
    conv_tile(tid__, PIN(17 + which) + (size_t)l * 512 * 1024, 1024, 32 * tj, kt * 128, which == 2 ? PIN(16) + l * 128 : nullptr, (u16*)(ws + W_O) + (size_t)which * 1024 * 512, 512, tj * 32, sm, 127, 1.f - p.lam_init[opaque_uniform(l)]);
    return;
  }
  jid -= 384;
  {
    const int tj = jid >> 3, kt = jid & 7;
    conv_tile(tid__, PIN(20) + (size_t)l * 1024 * 1024, 1024, 32 * tj, kt * 128, nullptr, (u16*)(ws + W_OUT), 1024, tj * 32, sm);
  }
}

DI void phase0(const int wvu__, const Params& p, unsigned char* smem) {
  FRESH_TID(tid__, wvu__);
  const int bid_ = BIDX, gd_ = GDIM;
  const int tid = tid__;
  constexpr int NJ = CONV_JOBS + 192 + 16 + 1;
  for (int job = bid_; job < NJ; job += gd_) {
    if (job < CONV_JOBS) { conv_job(tid__, p, 0, job, (u16*)smem); continue; }
    int j = job - CONV_JOBS;
    if (j < 192) {
      const int l = j / 48, cj = j % 48;
      float* sc = (float*)smem;
      float* red = (float*)(smem + 32768);
      __syncthreads();
      for (int e = tid; e < 8192; e += 256) sc[e] = siluf_(PIN(1)[e]);
      __syncthreads();
      const int col = tid & 63, kq = tid >> 6;
      const float* w = PIN(2) + (size_t)l * D * 3072 + cj * 64 + col;
      float a[8];
#pragma unroll
      for (int b = 0; b < 8; ++b) a[b] = 0.f;
      for (int k = kq * 256; k < kq * 256 + 256; ++k) {
        const float wv = w[(size_t)k * 3072];
#pragma unroll
        for (int b = 0; b < 8; ++b) a[b] += sc[b * 1024 + k] * wv;
      }
#pragma unroll
      for (int b = 0; b < 8; ++b) red[(kq * 8 + b) * 64 + col] = a[b];
      __syncthreads();
      float* mod = (float*)(p.ws + OFF_MOD);
      for (int e = tid; e < 512; e += 256) {
        const int b = e >> 6, c = e & 63;
        const float v = red[(0 * 8 + b) * 64 + c] + red[(1 * 8 + b) * 64 + c] + red[(2 * 8 + b) * 64 + c] + red[(3 * 8 + b) * 64 + c];
        mod[((size_t)l * 8 + b) * 3072 + cj * 64 + c] = v + PIN(3)[l * 3072 + cj * 64 + c];
      }
      continue;
    }
    j -= 192;
    if (j < 16) {
      float2* rt = (float2*)(p.ws + OFF_ROPE);
      for (int e = j * 4096 + tid; e < (j + 1) * 4096; e += 256) {
        const int pos = e >> 4, i = e & 15;
        const float ang = (float)pos * p.inv_freq[i];
        const double rev = (double)ang * 0.15915494309189535;
        const float fr = (float)(rev - floor(rev));
        rt[e] = make_float2(__builtin_amdgcn_cosf(fr), __builtin_amdgcn_sinf(fr));
      }
      continue;
    }
    {
      float* bt = (float*)(p.ws + OFF_BT);
      for (int e = tid; e < 12 * BTN; e += 256) {
        const int hh = e / BTN, idx = e % BTN, rel = idx - BTO;
        const int n = rel < 0 ? -rel : rel;
        int bucket = rel > 0 ? 16 : 0;
        if (n < 8) bucket += n;
        else { int k = 8 + (31 - __clz(n * n)) - 6; bucket += k > 15 ? 15 : k; }
        float v = PIN(21)[bucket * 12 + hh] * LOG2E;
        if (hh < 8 && n > 128) v = -1e30f;
        bt[hh * BTS + idx] = v;
      }
      if (tid < 4) {
        const int l = tid;
        float s1 = 0.f, s2 = 0.f;
        for (int i = 0; i < 64; ++i) { s1 += PIN(12)[l * 64 + i] * PIN(13)[l * 64 + i]; s2 += PIN(14)[l * 64 + i] * PIN(15)[l * 64 + i]; }
        ((float*)(p.ws + OFF_LAM))[l] = expf(s1) - expf(s2) + p.lam_init[l];
      }
    }
  }
}

DI void phase_norm(const int wvu__, const Params& p, int l, unsigned char* smem) {
  FRESH_TID(tid__, wvu__);
  const int bid_ = BIDX, gd_ = GDIM;
  if (l >= 0 && l + 1 < DEPTH)
    for (int job = bid_; job < CONV_JOBS; job += gd_) conv_job(tid__, p, l + 1, job, (u16*)smem);
  const int lane = tid__ & 63, wave = tid__ >> 6;
  const float* xsrc = (l <= 0) ? PIN(0) : p.out;
  const float* mod = (const float*)(p.ws + OFF_MOD);
  const u16* Y = (const u16*)(p.ws + A_Y);
  u16* H = (u16*)(p.ws + A_H);
  for (int row = bid_ * 4 + wave; row < T; row += gd_ * 4) {
    const int b = row >> 12;
    float4 xv[4];
#pragma unroll
    for (int i = 0; i < 4; ++i) xv[i] = *(const float4*)(xsrc + (size_t)row * D + lane * 4 + 256 * i);
    if (l >= 0) {
      float yv[4][4];
      float ss = 0.f;
#pragma unroll
      for (int i = 0; i < 4; ++i) {
        const u32x2 t = *(const u32x2*)(Y + (size_t)row * D + lane * 4 + 256 * i);
        yv[i][0] = bflo(t.x); yv[i][1] = bfhi(t.x); yv[i][2] = bflo(t.y); yv[i][3] = bfhi(t.y);
        ss += yv[i][0] * yv[i][0] + yv[i][1] * yv[i][1] + yv[i][2] * yv[i][2] + yv[i][3] * yv[i][3];
      }
      ss = wave_sum(lane, ss);
      const float rstd = rsqrtf(ss * (1.f / 1024.f) + EPS);
      const float* gate = mod + ((size_t)l * 8 + b) * 3072 + 2048;
      const float* gp = PIN(5) + l * D;
#pragma unroll
      for (int i = 0; i < 4; ++i) {
        const int c = lane * 4 + 256 * i;
        const float4 gt = *(const float4*)(gate + c), gg = *(const float4*)(gp + c);
        xv[i].x += gt.x * (yv[i][0] * rstd * gg.x); xv[i].y += gt.y * (yv[i][1] * rstd * gg.y);
        xv[i].z += gt.z * (yv[i][2] * rstd * gg.z); xv[i].w += gt.w * (yv[i][3] * rstd * gg.w);
        *(float4*)(p.out + (size_t)row * D + c) = xv[i];
      }
    }
    if (l + 1 < DEPTH) {
      float ss = 0.f;
#pragma unroll
      for (int i = 0; i < 4; ++i) ss += xv[i].x * xv[i].x + xv[i].y * xv[i].y + xv[i].z * xv[i].z + xv[i].w * xv[i].w;
      ss = wave_sum(lane, ss);
      const float rstd = rsqrtf(ss * (1.f / 1024.f) + EPS);
      const float* sh = mod + ((size_t)(l + 1) * 8 + b) * 3072;
      const float* gp = PIN(4) + (l + 1) * D;
#pragma unroll
      for (int i = 0; i < 4; ++i) {
        const int c = lane * 4 + 256 * i;
        const float4 s0 = *(const float4*)(sh + c), s1 = *(const float4*)(sh + 1024 + c), gg = *(const float4*)(gp + c);
        const float h0 = xv[i].x * rstd * gg.x * (1.f + s1.x) + s0.x, h1 = xv[i].y * rstd * gg.y * (1.f + s1.y) + s0.y;
        const float h2 = xv[i].z * rstd * gg.z * (1.f + s1.z) + s0.z, h3 = xv[i].w * rstd * gg.w * (1.f + s1.w) + s0.w;
        u32x2 o; o.x = pk2(h0, h1); o.y = pk2(h2, h3);
        *(u32x2*)(H + (size_t)row * D + c) = o;
      }
    }
  }
}

constexpr float QS64 = 0.125f * LOG2E;
constexpr float QS96 = 0.10206207261596575f * LOG2E;
template <int MT> DI void scale_acc(f32x16 (&acc)[2][MT], float s) {
#pragma unroll
  for (int a = 0; a < 2; ++a)
#pragma unroll
    for (int b = 0; b < MT; ++b)
#pragma unroll
      for (int i = 0; i < 16; ++i) acc[a][b][i] *= s;
}
template <int MT> DI void silu_acc(f32x16 (&acc)[2][MT]) {
#pragma unroll
  for (int a = 0; a < 2; ++a)
#pragma unroll
    for (int b = 0; b < MT; ++b)
#pragma unroll
      for (int i = 0; i < 16; ++i) acc[a][b][i] = siluf_(acc[a][b][i]);
}
DI void rope_tile(f32x16& t, int pos, int h, const float2* __restrict__ rt) {
#pragma unroll
  for (int i = 0; i < 8; ++i) {
    const int f = (i & 3) + 8 * (i >> 2) + 4 * h;
    const float2 cs = rt[pos * 16 + f];
    const float x1 = t[i], x2 = t[i + 8];
    t[i] = x1 * cs.x - x2 * cs.y;
    t[i + 8] = x2 * cs.x + x1 * cs.y;
  }
}
template <int E>
DI void p1_epi(const int tid__, const f32x16 (&acc)[2][4], u16* sC, int mode, u16* dst, int ld) {
  __syncthreads();
  if (mode == 3) {
    stage_transposed<4, E>(tid__, acc, sC); __syncthreads();
    store_rows(tid__, sC, dst + E * 64, ld, ColTok());
  } else {
    if (mode == 1) stage_normal<4, E, FSilu>(tid__, acc, sC);
    else if (mode == 2) { FScale fs; fs.s = QS64; stage_normal<4, E, FScale>(tid__, acc, sC, fs); }
    else stage_normal<4, E>(tid__, acc, sC);
    __syncthreads();
    if (mode == 4) {
      for (int idx = tid__; idx < 512; idx += 256) {
        const int row = idx >> 2, ch = idx & 3;
        const u32x4 v = *(const u32x4*)(sC + row * 136 + ch * 8);
        u16* kr = dst + (size_t)((row >> 6) * 128 + E * 64 + (row & 63)) * 768 + 64 + ch * 8;
#pragma unroll
        for (int hd = 0; hd < 8; ++hd) *(u32x4*)(kr + hd * 96) = v;
      }
    } else store_rows(tid__, sC, dst + (size_t)(E * 64) * ld, ld, ColId(), 64);
  }
}
DI void phase_p1(const int wvu__, const Params& p, unsigned char* smem) {
  FRESH_TID(tid__, wvu__);
  const int bid_ = BIDX, gd_ = GDIM;
  unsigned char* ws = p.ws;
  u16* sW = (u16*)smem; u16* sX = (u16*)(smem + 18432); u16* sC = (u16*)smem;
  const int lane = tid__ & 63, wave = tid__ >> 6, r = lane & 31, h = lane >> 5, wn = wave & 1, wm = wave >> 1;
  const float2* rt = (const float2*)(ws + OFF_ROPE);
  for (int jl = bid_ >> 3; jl < 16 * 34; jl += gd_ >> 3) {
    const int g8 = jl / 136, q8 = jl % 136;
    const int mt = (g8 * 4 + (q8 & 3)) * 8 + (bid_ & 7), j = (g8 & 1) ? 33 - (q8 >> 2) : (q8 >> 2), m0 = mt * 256;
    f32x16 acc[2][4];
    zero_acc<4>(acc);
    gemm_loop<4>(tid__, acc, (const u16*)(ws + W_P1) + (size_t)j * 128 * 1024, 1024, (const u16*)(ws + A_H) + (size_t)m0 * 1024, 1024, 1024, sW, sX);
    const int b = m0 >> 12, s0 = m0 & 4095;
    int mode = 0; u16* dst; int ld;
    if (j < 3) { dst = (u16*)(ws + A_CQ) + (size_t)m0 * 384 + j * 128; ld = 384; }
    else if (j == 3) { mode = 4; dst = (u16*)(ws + A_KM) + (size_t)m0 * 768; ld = 768; }
    else if (j < 8) { mode = 1; dst = (u16*)(ws + A_Z) + (size_t)m0 * 1536 + (j - 4) * 128; ld = 1536; }
    else if (j < 12) { mode = 2; dst = (u16*)(ws + A_SQ) + (size_t)m0 * 512 + (j - 8) * 128; ld = 512; }
    else if (j == 12) { dst = (u16*)(ws + A_SK) + (size_t)m0 * 128; ld = 128; }
    else if (j == 13) { mode = 3; dst = (u16*)(ws + A_SVT) + (size_t)(b * 128) * S + s0; ld = S; }
    else if (j < 18) { mode = 1; dst = (u16*)(ws + A_Z) + (size_t)m0 * 1536 + 512 + (j - 14) * 128; ld = 1536; }
    else if (j < 22) { mode = 2; dst = (u16*)(ws + A_DQ) + (size_t)m0 * 512 + (j - 18) * 128; ld = 512; }
    else if (j < 26) { dst = (u16*)(ws + A_DK) + (size_t)m0 * 512 + (j - 22) * 128; ld = 512; }
    else if (j < 30) { mode = 3; dst = (u16*)(ws + A_DVT) + (size_t)(b * 512 + (j - 26) * 128) * S + s0; ld = S; }
    else { mode = 1; dst = (u16*)(ws + A_Z) + (size_t)m0 * 1536 + 1024 + (j - 30) * 128; ld = 1536; }
    if (mode == 4 && wn == 0) {
#pragma unroll
      for (int mi = 0; mi < 4; ++mi) rope_tile(acc[0][mi], s0 + wm * 128 + mi * 32 + r, h, rt);
    }
    p1_epi<0>(tid__, acc, sC, mode, dst, ld);
    p1_epi<1>(tid__, acc, sC, mode, dst, ld);
  }
}

struct ColKM { int base; DI int operator()(int c) const { return (base + (c >> 6)) * 96 + (c & 63); } };
template <int E>
DI void p2_epi(const int tid__, const f32x16 (&acc)[2][4], u16* sC, unsigned char* ws, bool isq, int nt, int m0, int b, int s0) {
  __syncthreads();
  if (isq) {
    stage_normal<4, E>(tid__, acc, sC); __syncthreads();
    store_rows(tid__, sC, (u16*)(ws + A_MQ) + (size_t)(m0 + E * 64) * 768 + nt * 128, 768, ColId(), 64);
  } else if (nt - 6 < 4) {
    stage_normal<4, E>(tid__, acc, sC); __syncthreads();
    ColKM cm; cm.base = (nt - 6) * 2;
    store_rows(tid__, sC, (u16*)(ws + A_KM) + (size_t)(m0 + E * 64) * 768, 768, cm, 64);
  } else {
    stage_transposed<4, E>(tid__, acc, sC); __syncthreads();
    store_rows(tid__, sC, (u16*)(ws + A_MVT) + (size_t)(b * 512 + (nt - 10) * 128) * S + s0 + E * 64, S, ColTok());
  }
}
DI void phase_p2(const int wvu__, const Params& p, unsigned char* smem) {
  const int bid_ = BIDX, gd_ = GDIM;
  unsigned char* ws = p.ws;
  u16* sW = (u16*)smem; u16* sX = (u16*)(smem + 18432); u16* sC = (u16*)smem;
  float* sR = (float*)(smem + 55296);
  const float2* rt = (const float2*)(ws + OFF_ROPE);
  const u16* CQ = (const u16*)(ws + A_CQ);
  for (int jl = bid_ >> 3; jl < 16 * 14; jl += gd_ >> 3) {
    FRESH_TID(tid__, wvu__);
    const int tid = tid__, lane = tid & 63, wave = tid >> 6, r = lane & 31, h = lane >> 5, wn = wave & 1, wm = wave >> 1;
    const int mt = (jl / 14) * 8 + (bid_ & 7), nt = jl % 14, m0 = mt * 256;
    const bool isq = nt < 6;
    __syncthreads();
    {
      const int ncol = isq ? 256 : 128, c0 = isq ? 0 : 256;
      const int sub = tid & 15, rb = tid >> 4;
#pragma unroll 4
      for (int it = 0; it < 16; ++it) {
        const int row = rb + 16 * it;
        const u16* src_ = CQ + (size_t)(m0 + row) * 384 + c0 + sub * 8;
        u32x4 v = *(const u32x4*)src_;
        u32x4 v2 = {0u, 0u, 0u, 0u};
        if (isq) v2 = *(const u32x4*)(src_ + 128);
        const u32 w[8] = {v.x, v.y, v.z, v.w, v2.x, v2.y, v2.z, v2.w};
        float ss = 0.f;
#pragma unroll
        for (int q = 0; q < 8; ++q) { const float a = bflo(w[q]), bb = bfhi(w[q]); ss += a * a + bb * bb; }
        ss += lane_xor(lane, ss, 1); ss += lane_xor(lane, ss, 2); ss += lane_xor(lane, ss, 4); ss += lane_xor(lane, ss, 8);
        if (sub == 0) sR[row] = rsqrtf(ss / (float)ncol + EPS);
      }
    }
    f32x16 acc[2][4];
    zero_acc<4>(acc);
    if (isq) gemm_loop<4>(tid__, acc, (const u16*)(ws + W_UQ) + (size_t)nt * 128 * 256, 256, CQ + (size_t)m0 * 384, 384, 256, sW, sX);
    else gemm_loop<4>(tid__, acc, (const u16*)(ws + W_UKV) + (size_t)(nt - 6) * 128 * 128, 128, CQ + (size_t)m0 * 384 + 256, 384, 128, sW, sX);
    const int s0 = m0 & 4095, b = m0 >> 12;
#pragma unroll
    for (int mi = 0; mi < 4; ++mi) {
      float rs = sR[wm * 128 + mi * 32 + r];
      if (isq) rs *= QS96;
#pragma unroll
      for (int ni = 0; ni < 2; ++ni)
#pragma unroll
        for (int i = 0; i < 16; ++i) acc[ni][mi][i] *= rs;
    }
    if (isq) {
#pragma unroll
      for (int ni = 0; ni < 2; ++ni) {
        const int sj = nt * 4 + wn * 2 + ni;
        if (sj % 3 == 2) {
#pragma unroll
          for (int mi = 0; mi < 4; ++mi) rope_tile(acc[ni][mi], s0 + wm * 128 + mi * 32 + r, h, rt);
        }
      }
    }
    p2_epi<0>(tid__, acc, sC, ws, isq, nt, m0, b, s0);
    p2_epi<1>(tid__, acc, sC, ws, isq, nt, m0, b, s0);
  }
}

template <int DQK, int DV, int MODE>
DI void attn_pass(const int tid__, f32x16 (&O)[DV / 32], float& l_tot, const u16* __restrict__ Qp, int ldq, const u16* __restrict__ Kp, int ldk,
                  const u16* __restrict__ VTp, int kt_lo, int kt_hi, int q0, float m_init, const float* sB, float cL, float cR, u16* sK, u16* sVT) {
  constexpr int KS = DQK / 16, KST = DQK + 8, NKI = DQK / 32, NVI = DV / 32, NV = DV / 32;
  constexpr bool LATEW = (MODE != 2);
  const int tid = tid__, lane = tid & 63, wave = tid >> 6, r = lane & 31, h = lane >> 5;
  const int qrow = wave * 32 + r;
  bf16x8 qf[KS];
  {
    const unsigned qo = (unsigned)(qrow * ldq + h * 8) * 2u;
#pragma unroll
    for (int ks = 0; ks < KS; ++ks) qf[ks] = *(const bf16x8*)((const char*)Qp + qo + ks * 32);
  }
#pragma unroll
  for (int db = 0; db < NV; ++db)
#pragma unroll
    for (int i = 0; i < 16; ++i) O[db][i] = 0.f;
  float m_ref = m_init, l_run = (MODE == 1 && h == 0) ? 1.f : 0.f, cb = 0.f;
  f32x16 cinit;
  const unsigned kgo = (unsigned)((tid >> 2) * ldk + (tid & 3) * 8) * 2u, kso = (unsigned)((tid >> 2) * KST + (tid & 3) * 8) * 2u;
  const unsigned vgo = (unsigned)((tid >> 3) * S + (tid & 7) * 8) * 2u, vso = (unsigned)((tid >> 3) * 72 + (tid & 7) * 8) * 2u;
  const char* kb_ = (const char*)Kp; const char* vb_ = (const char*)VTp;
  constexpr int KBYTES = 64 * KST * 2, VBYTES = DV * 72 * 2;
  u32x4 rk[NKI], rv[NVI];
#pragma unroll
  for (int i = 0; i < NKI; ++i) rk[i] = *(const u32x4*)(kb_ + (size_t)(kt_lo * 64 * ldk) * 2 + i * 64 + kgo);
#pragma unroll
  for (int i = 0; i < NVI; ++i) rv[i] = *(const u32x4*)(vb_ + (size_t)(i * 32 * S + kt_lo * 64) * 2 + vgo);
  const int pr = (r & ~12) | ((r & 4) << 1) | ((r & 8) >> 1);
  const unsigned kfo = (unsigned)(pr * KST + h * 8) * 2u, vfo = (unsigned)(r * 72 + h * 8) * 2u;
  __syncthreads();
#pragma unroll
  for (int i = 0; i < NKI; ++i) *(u32x4*)((char*)sK + kso + i * 64) = rk[i];
#pragma unroll
  for (int i = 0; i < NVI; ++i) *(u32x4*)((char*)sVT + vso + i * (32 * 72 * 2)) = rv[i];
  __syncthreads();
  if (MODE != 1) {
    f32x16 e[2];
#pragma unroll
    for (int kb = 0; kb < 2; ++kb) {
#pragma unroll
      for (int i = 0; i < 16; ++i) e[kb][i] = 0.f;
#pragma unroll
      for (int ks = 0; ks < KS; ++ks) {
        const bf16x8 kf = *(const bf16x8*)((const char*)sK + kfo + kb * (32 * KST * 2) + ks * 32);
        e[kb] = MFMA(kf, qf[ks], e[kb]);
      }
    }
    float mx = e[0][0];
#pragma unroll
    for (int i = 1; i < 16; ++i) mx = fmaxf(mx, e[0][i]);
#pragma unroll
    for (int i = 0; i < 16; ++i) mx = fmaxf(mx, e[1][i]);
    m_ref = xhalf_max(mx);
  }
#pragma unroll
  for (int i = 0; i < 16; ++i) { float t = -m_ref; asm volatile("" : "+v"(t)); cinit[i] = t; }
  int cur = 0;
  for (int kt = kt_lo; kt < kt_hi; ++kt, cur ^= 1) {
    const char* cK = (const char*)sK + cur * KBYTES;
    const char* cV = (const char*)sVT + cur * VBYTES;
    {
      const int ktn = (kt + 1 < kt_hi) ? kt + 1 : kt;
#pragma unroll
      for (int i = 0; i < NKI; ++i) rk[i] = *(const u32x4*)(kb_ + (size_t)(ktn * 64 * ldk) * 2 + i * 64 + kgo);
#pragma unroll
      for (int i = 0; i < NVI; ++i) rv[i] = *(const u32x4*)(vb_ + (size_t)(i * 32 * S + ktn * 64) * 2 + vgo);
    }
    const bool wskip = (MODE == 1) && ((kt * 64 > q0 + (qrow | 31) + 128) || (kt * 64 + 63 < q0 + (qrow & ~31) - 128));
    if (!wskip) {
    bool nearb = (MODE == 1);
    if (MODE == 2) {
      const int k0 = kt * 64;
      float c = 0.f;
      if (k0 - (q0 + 127) >= 91) c = cR; else if (q0 - (k0 + 63) >= 91) c = cL; else nearb = true;
      if (c != cb) {
        cb = c;
#pragma unroll
        for (int i = 0; i < 16; ++i) { float t = cb - m_ref; asm volatile("" : "+v"(t)); cinit[i] = t; }
      }
    }
    f32x16 s[2];
#pragma unroll
    for (int kb = 0; kb < 2; ++kb) {
      const bf16x8 kf0 = *(const bf16x8*)(cK + kfo + kb * (32 * KST * 2));
      s[kb] = MFMA(kf0, qf[0], cinit);
#pragma unroll
      for (int ks = 1; ks < KS; ++ks) {
        const bf16x8 kf = *(const bf16x8*)(cK + kfo + kb * (32 * KST * 2) + ks * 32);
        s[kb] = MFMA(kf, qf[ks], s[kb]);
      }
    }
    if (MODE != 0 && nearb) {
      const float* bp = sB + (kt * 64 + 8 * h - (q0 + qrow) + BTO);
#pragma unroll
      for (int kb = 0; kb < 2; ++kb)
#pragma unroll
        for (int i = 0; i < 16; ++i) s[kb][i] += bp[kb * 32 + (i & 7) + 16 * (i >> 3)];
    }
    float mx = s[0][0];
#pragma unroll
    for (int i = 1; i < 16; ++i) mx = fmaxf(mx, s[0][i]);
#pragma unroll
    for (int i = 0; i < 16; ++i) mx = fmaxf(mx, s[1][i]);
    mx = xhalf_max(mx);
    if (__builtin_expect(__any(mx > 8.f), 0)) {
      const float delta = fmaxf(mx, 0.f);
      const float alpha = fexp2(-delta);
      m_ref += delta;
      l_run *= alpha;
#pragma unroll
      for (int kb = 0; kb < 2; ++kb)
#pragma unroll
        for (int i = 0; i < 16; ++i) s[kb][i] -= delta;
#pragma unroll
      for (int db = 0; db < NV; ++db)
#pragma unroll
        for (int i = 0; i < 16; ++i) O[db][i] *= alpha;
#pragma unroll
      for (int i = 0; i < 16; ++i) { float t = cb - m_ref; asm volatile("" : "+v"(t)); cinit[i] = t; }
    }
    if (!LATEW) {
#pragma unroll
      for (int i = 0; i < NKI; ++i) *(u32x4*)((char*)sK + (cur ^ 1) * KBYTES + kso + i * 64) = rk[i];
#pragma unroll
      for (int i = 0; i < NVI; ++i) *(u32x4*)((char*)sVT + (cur ^ 1) * VBYTES + vso + i * (32 * 72 * 2)) = rv[i];
    }
    float ls = 0.f;
#pragma unroll
    for (int st = 0; st < 4; ++st) {
      const int kb = st >> 1, o = (st & 1) * 8;
      float pe[8];
#pragma unroll
      for (int j = 0; j < 8; ++j) { pe[j] = fexp2(s[kb][o + j]); ls += pe[j]; }
      union { u32 u[4]; bf16x8 v; } pf;
      pf.u[0] = pk2(pe[0], pe[1]); pf.u[1] = pk2(pe[2], pe[3]); pf.u[2] = pk2(pe[4], pe[5]); pf.u[3] = pk2(pe[6], pe[7]);
#pragma unroll
      for (int db = 0; db < NV; ++db) {
        const bf16x8 vf = *(const bf16x8*)(cV + vfo + db * (32 * 72 * 2) + st * 32);
        O[db] = MFMA(vf, pf.v, O[db]);
      }
    }
    l_run += ls;
    }
    if (LATEW) {
#pragma unroll
      for (int i = 0; i < NKI; ++i) *(u32x4*)((char*)sK + (cur ^ 1) * KBYTES + kso + i * 64) = rk[i];
#pragma unroll
      for (int i = 0; i < NVI; ++i) *(u32x4*)((char*)sVT + (cur ^ 1) * VBYTES + vso + i * (32 * 72 * 2)) = rv[i];
    }
    __syncthreads();
  }
  l_tot = xhalf_sum(l_run);
}
template <int DQK, int DV>
DI void attn_pass2(const int tid__, f32x16 (&O)[2][DV / 32], float (&l_tot)[2], const u16* __restrict__ Qp, int ldq, const u16* __restrict__ Kp, int ldk,
                   const u16* __restrict__ VTp, int kt_lo, int kt_hi, u16* sK, u16* sVT) {
  constexpr int KS = DQK / 16, KST = DQK + 8, NKI = DQK / 32, NVI = DV / 32, NV = DV / 32;
  const int tid = tid__, lane = tid & 63, wave = tid >> 6, r = lane & 31, h = lane >> 5;
  bf16x8 qf[2][KS];
#pragma unroll
  for (int qi = 0; qi < 2; ++qi) {
    const unsigned qo = (unsigned)((wave * 64 + qi * 32 + r) * ldq + h * 8) * 2u;
#pragma unroll
    for (int ks = 0; ks < KS; ++ks) qf[qi][ks] = *(const bf16x8*)((const char*)Qp + qo + ks * 32);
  }
#pragma unroll
  for (int qi = 0; qi < 2; ++qi)
#pragma unroll
    for (int db = 0; db < NV; ++db)
#pragma unroll
      for (int i = 0; i < 16; ++i) O[qi][db][i] = 0.f;
  float m_ref[2], l_run[2] = {0.f, 0.f};
  f32x16 cinit[2];
  const unsigned kgo = (unsigned)((tid >> 2) * ldk + (tid & 3) * 8) * 2u, kso = (unsigned)((tid >> 2) * KST + (tid & 3) * 8) * 2u;
  const unsigned vgo = (unsigned)((tid >> 3) * S + (tid & 7) * 8) * 2u, vso = (unsigned)((tid >> 3) * 72 + (tid & 7) * 8) * 2u;
  const char* kb_ = (const char*)Kp; const char* vb_ = (const char*)VTp;
  constexpr int KBYTES = 64 * KST * 2, VBYTES = DV * 72 * 2;
  u32x4 rk[NKI], rv[NVI];
#pragma unroll
  for (int i = 0; i < NKI; ++i) rk[i] = *(const u32x4*)(kb_ + (size_t)(kt_lo * 64 * ldk) * 2 + i * 64 + kgo);
#pragma unroll
  for (int i = 0; i < NVI; ++i) rv[i] = *(const u32x4*)(vb_ + (size_t)(i * 32 * S + kt_lo * 64) * 2 + vgo);
  const int pr = (r & ~12) | ((r & 4) << 1) | ((r & 8) >> 1);
  const unsigned kfo = (unsigned)(pr * KST + h * 8) * 2u, vfo = (unsigned)(r * 72 + h * 8) * 2u;
  __syncthreads();
#pragma unroll
  for (int i = 0; i < NKI; ++i) *(u32x4*)((char*)sK + kso + i * 64) = rk[i];
#pragma unroll
  for (int i = 0; i < NVI; ++i) *(u32x4*)((char*)sVT + vso + i * (32 * 72 * 2)) = rv[i];
  __syncthreads();
#pragma unroll
  for (int qi = 0; qi < 2; ++qi) {
    f32x16 e[2];
#pragma unroll
    for (int kb = 0; kb < 2; ++kb) {
#pragma unroll
      for (int i = 0; i < 16; ++i) e[kb][i] = 0.f;
#pragma unroll
      for (int ks = 0; ks < KS; ++ks) {
        const bf16x8 kf = *(const bf16x8*)((const char*)sK + kfo + kb * (32 * KST * 2) + ks * 32);
        e[kb] = MFMA(kf, qf[qi][ks], e[kb]);
      }
    }
    float mx = e[0][0];
#pragma unroll
    for (int i = 1; i < 16; ++i) mx = fmaxf(mx, e[0][i]);
#pragma unroll
    for (int i = 0; i < 16; ++i) mx = fmaxf(mx, e[1][i]);
    m_ref[qi] = xhalf_max(mx);
#pragma unroll
    for (int i = 0; i < 16; ++i) { float t = -m_ref[qi]; asm volatile("" : "+v"(t)); cinit[qi][i] = t; }
  }
  int cur = 0;
  for (int kt = kt_lo; kt < kt_hi; ++kt, cur ^= 1) {
    const char* cK = (const char*)sK + cur * KBYTES;
    const char* cV = (const char*)sVT + cur * VBYTES;
    {
      const int ktn = (kt + 1 < kt_hi) ? kt + 1 : kt;
#pragma unroll
      for (int i = 0; i < NKI; ++i) rk[i] = *(const u32x4*)(kb_ + (size_t)(ktn * 64 * ldk) * 2 + i * 64 + kgo);
#pragma unroll
      for (int i = 0; i < NVI; ++i) rv[i] = *(const u32x4*)(vb_ + (size_t)(i * 32 * S + ktn * 64) * 2 + vgo);
    }
#pragma unroll
    for (int qi = 0; qi < 2; ++qi) {
      f32x16 s[2];
#pragma unroll
      for (int kb = 0; kb < 2; ++kb) {
        const bf16x8 kf0 = *(const bf16x8*)(cK + kfo + kb * (32 * KST * 2));
        s[kb] = MFMA(kf0, qf[qi][0], cinit[qi]);
#pragma unroll
        for (int ks = 1; ks < KS; ++ks) {
          const bf16x8 kf = *(const bf16x8*)(cK + kfo + kb * (32 * KST * 2) + ks * 32);
          s[kb] = MFMA(kf, qf[qi][ks], s[kb]);
        }
      }
      float mx = s[0][0];
#pragma unroll
      for (int i = 1; i < 16; ++i) mx = fmaxf(mx, s[0][i]);
#pragma unroll
      for (int i = 0; i < 16; ++i) mx = fmaxf(mx, s[1][i]);
      mx = xhalf_max(mx);
      if (__builtin_expect(__any(mx > 8.f), 0)) {
        const float delta = fmaxf(mx, 0.f);
        const float alpha = fexp2(-delta);
        m_ref[qi] += delta;
        l_run[qi] *= alpha;
#pragma unroll
        for (int kb = 0; kb < 2; ++kb)
#pragma unroll
          for (int i = 0; i < 16; ++i) s[kb][i] -= delta;
#pragma unroll
        for (int db = 0; db < NV; ++db)
#pragma unroll
          for (int i = 0; i < 16; ++i) O[qi][db][i] *= alpha;
#pragma unroll
        for (int i = 0; i < 16; ++i) { float t = -m_ref[qi]; asm volatile("" : "+v"(t)); cinit[qi][i] = t; }
      }
      float ls = 0.f;
#pragma unroll
      for (int st = 0; st < 4; ++st) {
        const int kb = st >> 1, o = (st & 1) * 8;
        float pe[8];
#pragma unroll
        for (int j = 0; j < 8; ++j) { pe[j] = fexp2(s[kb][o + j]); ls += pe[j]; }
        union { u32 u[4]; bf16x8 v; } pf;
        pf.u[0] = pk2(pe[0], pe[1]); pf.u[1] = pk2(pe[2], pe[3]); pf.u[2] = pk2(pe[4], pe[5]); pf.u[3] = pk2(pe[6], pe[7]);
#pragma unroll
        for (int db = 0; db < NV; ++db) {
          const bf16x8 vf = *(const bf16x8*)(cV + vfo + db * (32 * 72 * 2) + st * 32);
          O[qi][db] = MFMA(vf, pf.v, O[qi][db]);
        }
      }
      l_run[qi] += ls;
      if (qi == 0) {
#pragma unroll
        for (int i = 0; i < NKI; ++i) *(u32x4*)((char*)sK + (cur ^ 1) * KBYTES + kso + i * 64) = rk[i];
#pragma unroll
        for (int i = 0; i < NVI; ++i) *(u32x4*)((char*)sVT + (cur ^ 1) * VBYTES + vso + i * (32 * 72 * 2)) = rv[i];
      }
    }
    __syncthreads();
  }
#pragma unroll
  for (int qi = 0; qi < 2; ++qi) l_tot[qi] = xhalf_sum(l_run[qi]);
}
template <int NV>
DI void attn_store(const int tid__, const f32x16 (&O)[NV], float rowscale, u16* Zp, int wrows = 32, int roff = 0) {
  const int lane = tid__ & 63, wave = tid__ >> 6, r = lane & 31, h = lane >> 5;
  u16* zr = (u16*)((char*)Zp + (unsigned)((wave * wrows + roff + r) * 1536 + 4 * h) * 2u);
#pragma unroll
  for (int db = 0; db < NV; ++db)
#pragma unroll
    for (int g = 0; g < 4; ++g) {
      const int d = db * 32 + 8 * g;
      const u32x2 z = *(const u32x2*)(zr + d);
      const float c0 = rowscale, c1 = rowscale, c2 = rowscale, c3 = rowscale;
      u32x2 o;
      o.x = pk2(O[db][4 * g] * c0 * bflo(z.x), O[db][4 * g + 1] * c1 * bfhi(z.x));
      o.y = pk2(O[db][4 * g + 2] * c2 * bflo(z.y), O[db][4 * g + 3] * c3 * bfhi(z.y));
      *(u32x2*)(zr + d) = o;
    }
}
constexpr int CTR_WORD0 = 4096;
DI int fetch_job(const int tid_, unsigned* ctr, volatile int* sJ) {
  __syncthreads();
  if (tid_ == 0) *sJ = (int)__hip_atomic_fetch_add(ctr, 1u, __ATOMIC_RELAXED, __HIP_MEMORY_SCOPE_AGENT);
  __syncthreads();
  return *sJ;
}
DI int xcd_remap(int j, int n) { return (j & 7) * (n >> 3) + (j >> 3); }
DI void phase_p3(const int wvu__, const Params& p, int l, unsigned char* smem) {
  const int bid_ = BIDX, gd_ = GDIM;
  unsigned char* ws = p.ws;
  u16* sK = (u16*)smem; u16* sVT = (u16*)(smem + SM_ATT_V);
  float* sB = (float*)(smem + SM_ATT_B);
  const float* BT = (const float*)(ws + OFF_BT);
  u16* Z = (u16*)(ws + A_Z);
  volatile int* sJ = (volatile int*)(smem + 66032);
  unsigned* const ctr0 = (unsigned*)(ws + OFF_BAR) + CTR_WORD0;
  const int qx = bid_ & 7;
#if !defined(P3SEL) || P3SEL == 0
  {
    const float lam = ((const float*)(ws + OFF_LAM))[l];
    for (;;) {
      FRESH_TID(tA, wvu__);
      const int jt = fetch_job(tA, ctr0 + ((l * 3 + 0) * 8 + qx) * 16, sJ);
      if (jt >= 128) break;
      const int job = qx * 128 + jt;
      const int qb = job & 31, hd = (job >> 5) & 3, b = job >> 7;
      const size_t tok0 = (size_t)b * S + qb * 128;
      __syncthreads();
      for (int e = tA; e < BTN; e += 256) sB[e] = BT[(8 + hd) * BTS + e];
      const float cL = BT[(8 + hd) * BTS + 0], cR = BT[(8 + hd) * BTS + BTN - 1];
      const u16* VT = (const u16*)(ws + A_DVT) + (size_t)(b * 512 + hd * 128) * S;
      char* so0 = (char*)(ws + A_O0) + (size_t)bid_ * 32768;
      const unsigned so0l = (unsigned)tA * 128u;
#pragma unroll 1
      for (int c = 0; c < 2; ++c) {
        f32x16 O[4];
        float lt;
        attn_pass<64, 128, 2>(tA, O, lt, (const u16*)(ws + A_DQ) + tok0 * 512 + hd * 128 + c * 64, 512, (const u16*)(ws + A_DK) + (size_t)b * S * 512 + hd * 128 + c * 64, 512,
                              VT, 0, 64, qb * 128, -1e30f, sB, cL, cR, sK, sVT);
        if (c == 0) {
          const float inv = 1.f / lt;
#pragma unroll
          for (int db = 0; db < 4; ++db)
#pragma unroll
            for (int i = 0; i < 8; i += 4) {
              u32x4 v;
              v.x = pk2(O[db][2 * i] * inv, O[db][2 * i + 1] * inv); v.y = pk2(O[db][2 * i + 2] * inv, O[db][2 * i + 3] * inv);
              v.z = pk2(O[db][2 * i + 4] * inv, O[db][2 * i + 5] * inv); v.w = pk2(O[db][2 * i + 6] * inv, O[db][2 * i + 7] * inv);
              *(u32x4*)(so0 + so0l + (db * 8 + i) * 4) = v;
            }
        } else {
          const float inv = lam / lt;
          float ss = 0.f;
          unsigned so0r = so0l; asm volatile("" : "+v"(so0r));
#pragma unroll
          for (int db = 0; db < 4; ++db)
#pragma unroll
            for (int i4 = 0; i4 < 8; i4 += 4) {
              const u32x4 v = *(const u32x4*)(so0 + so0r + (db * 8 + i4) * 4);
              const u32 w[4] = {v.x, v.y, v.z, v.w};
#pragma unroll
              for (int q = 0; q < 4; ++q) {
                const int i = i4 + q;
                const float a = bflo(w[q]) - O[db][2 * i] * inv, cc = bfhi(w[q]) - O[db][2 * i + 1] * inv;
                O[db][2 * i] = a; O[db][2 * i + 1] = cc; ss += a * a + cc * cc;
              }
            }
          ss = xhalf_sum(ss);
          const float rstd = rsqrtf(ss * (1.f / 128.f) + EPS);
          attn_store<4>(tA, O, rstd, Z + tok0 * 1536 + 1024 + hd * 128);
        }
      }
    }
  }
#endif
#if !defined(P3SEL) || P3SEL == 1
  for (;;) {
    FRESH_TID(tB, wvu__);
    const int jt = fetch_job(tB, ctr0 + ((l * 3 + 1) * 8 + qx) * 16, sJ);
    if (jt >= 128) break;
    const int job = qx * 128 + jt;
    const int qb = job & 15, hd = (job >> 4) & 7, b = job >> 7;
    const size_t tok0 = (size_t)b * S + qb * 256;
    f32x16 O[2][2];
    float lt[2];
    attn_pass2<96, 64>(tB, O, lt, (const u16*)(ws + A_MQ) + tok0 * 768 + hd * 96, 768, (const u16*)(ws + A_KM) + (size_t)b * S * 768 + hd * 96, 768,
                       (const u16*)(ws + A_MVT) + (size_t)(b * 512 + hd * 64) * S, 0, 64, sK, sVT);
    attn_store<2>(tB, O[0], 1.f / lt[0], Z + tok0 * 1536 + hd * 64, 64, 0);
    attn_store<2>(tB, O[1], 1.f / lt[1], Z + tok0 * 1536 + hd * 64, 64, 32);
  }
#endif
#if !defined(P3SEL) || P3SEL == 2
  for (;;) {
    FRESH_TID(tC, wvu__);
    const int jt = fetch_job(tC, ctr0 + ((l * 3 + 2) * 8 + qx) * 16, sJ);
    if (jt >= 256) break;
    const int job = qx * 256 + jt;
    const int qb = job & 31, hd = (job >> 5) & 7, b = job >> 8, kvh = hd >> 2;
    const size_t tok0 = (size_t)b * S + qb * 128;
    __syncthreads();
    for (int e = tC; e < BTN; e += 256) sB[e] = BT[hd * BTS + e];
    const int kt_lo = qb == 0 ? 0 : qb * 2 - 2, kt_hi = qb == 31 ? 64 : qb * 2 + 4;
    f32x16 O[2];
    float lt;
    attn_pass<64, 64, 1>(tC, O, lt, (const u16*)(ws + A_SQ) + tok0 * 512 + hd * 64, 512, (const u16*)(ws + A_SK) + (size_t)b * S * 128 + kvh * 64, 128,
                         (const u16*)(ws + A_SVT) + (size_t)(b * 128 + kvh * 64) * S, kt_lo, kt_hi, qb * 128, PIN(11)[l * 8 + hd] * LOG2E, sB, 0.f, 0.f, sK, sVT);
    attn_store<2>(tC, O, 1.f / lt, Z + tok0 * 1536 + 512 + hd * 64);
  }
#endif
}

DI void phase_p4(const int wvu__, const Params& p, unsigned char* smem) {
  FRESH_TID(tid__, wvu__);
  const int bid_ = BIDX, gd_ = GDIM;
  unsigned char* ws = p.ws;
  u16* sW = (u16*)smem; u16* sX = (u16*)(smem + 18432); u16* sC = (u16*)smem;
  const u16* WG = (const u16*)(ws + W_G); const u16* WO = (const u16*)(ws + W_O);
  const u16* H = (const u16*)(ws + A_H); const u16* Zs = (const u16*)(ws + A_Z);
  const int jstep = gd_ >> 3;
  GStage<2> st;
  {
    const int jl = bid_ >> 3;
    if (jl < 32 * 8) {
      const int mt = (jl >> 3) * 8 + (bid_ & 7), nt = jl & 7;
      gemm_prefetch<2>(tid__, st, WG + (size_t)(nt * 128) * 1024, 1024, H + (size_t)(mt * 128) * 1024, 1024);
    }
  }
  for (int jl = bid_ >> 3; jl < 32 * 8; jl += jstep) {
    const int mt = (jl >> 3) * 8 + (bid_ & 7), nt = jl & 7, m0 = mt * 128, n0 = nt * 128;
    const int jn = (jl + jstep < 32 * 8) ? jl + jstep : jl;
    const int m0n = ((jn >> 3) * 8 + (bid_ & 7)) * 128, n0n = (jn & 7) * 128;
    f32x16 macc[2][2];
    zero_acc<2>(macc);
#pragma unroll 1
    for (int j = 0; j < 3; ++j) {
      f32x16 acc[2][2];
      zero_acc<2>(acc);
      const u16* wg = WG + (size_t)(j * 1024 + n0) * 1024; const u16* xg = H + (size_t)m0 * 1024;
      const u16* wo = WO + (size_t)j * 1024 * 512 + (size_t)n0 * 512; const u16* xo = Zs + (size_t)m0 * 1536 + j * 512;
      gemm_loop_chain<2>(tid__, acc, st, wg, 1024, xg, 1024, 1024, sW, sX, wo, 512, xo, 1536);
      char* sg = (char*)(ws + A_O0) + (size_t)bid_ * 32768;
      const unsigned sgl = (unsigned)tid__ * 128u;
#pragma unroll
      for (int a = 0; a < 2; ++a)
#pragma unroll
        for (int b = 0; b < 2; ++b)
#pragma unroll
          for (int i = 0; i < 8; i += 4) {
            u32x4 v;
            v.x = pk2(sigmoidf_(acc[a][b][2 * i]), sigmoidf_(acc[a][b][2 * i + 1])); v.y = pk2(sigmoidf_(acc[a][b][2 * i + 2]), sigmoidf_(acc[a][b][2 * i + 3]));
            v.z = pk2(sigmoidf_(acc[a][b][2 * i + 4]), sigmoidf_(acc[a][b][2 * i + 5])); v.w = pk2(sigmoidf_(acc[a][b][2 * i + 6]), sigmoidf_(acc[a][b][2 * i + 7]));
            *(u32x4*)(sg + sgl + ((a * 2 + b) * 8 + i) * 4) = v;
          }
      zero_acc<2>(acc);
      unsigned sgr = sgl; asm volatile("" : "+v"(sgr));
      const u16* wnx = (j < 2) ? WG + (size_t)((j + 1) * 1024 + n0) * 1024 : WG + (size_t)n0n * 1024;
      const u16* xnx = (j < 2) ? xg : H + (size_t)m0n * 1024;
      gemm_loop_chain<2>(tid__, acc, st, wo, 512, xo, 1536, 512, sW, sX, wnx, 1024, xnx, 1024);
#pragma unroll
      for (int a = 0; a < 2; ++a)
#pragma unroll
        for (int b = 0; b < 2; ++b)
#pragma unroll
          for (int i4 = 0; i4 < 8; i4 += 4) {
            const u32x4 v = *(const u32x4*)(sg + sgr + ((a * 2 + b) * 8 + i4) * 4);
            const u32 w[4] = {v.x, v.y, v.z, v.w};
#pragma unroll
            for (int q = 0; q < 4; ++q) {
              const int i = i4 + q;
              macc[a][b][2 * i] += bflo(w[q]) * acc[a][b][2 * i];
              macc[a][b][2 * i + 1] += bfhi(w[q]) * acc[a][b][2 * i + 1];
            }
          }
    }
    __syncthreads();
    stage_normal<2>(tid__, macc, sC); __syncthreads();
    store_rows(tid__, sC, (u16*)(ws + A_M) + (size_t)m0 * 1024 + n0, 1024, ColId());
  }
}
DI void phase_p5(const int wvu__, const Params& p, unsigned char* smem) {
  FRESH_TID(tid__, wvu__);
  const int bid_ = BIDX, gd_ = GDIM;
  unsigned char* ws = p.ws;
  u16* sW = (u16*)smem; u16* sX = (u16*)(smem + 18432); u16* sC = (u16*)smem;
  for (int jl = bid_ >> 3; jl < 16 * 8; jl += gd_ >> 3) {
    const int mt = (jl >> 3) * 8 + (bid_ & 7), nt = jl & 7, m0 = mt * 256, n0 = nt * 128;
    f32x16 acc[2][4];
    zero_acc<4>(acc);
    gemm_loop<4>(tid__, acc, (const u16*)(ws + W_OUT) + (size_t)n0 * 1024, 1024, (const u16*)(ws + A_M) + (size_t)m0 * 1024, 1024, 1024, sW, sX);
    __syncthreads();
    stage_normal<4, 0>(tid__, acc, sC); __syncthreads();
    store_rows(tid__, sC, (u16*)(ws + A_Y) + (size_t)m0 * 1024 + n0, 1024, ColId(), 64);
    __syncthreads();
    stage_normal<4, 1>(tid__, acc, sC); __syncthreads();
    store_rows(tid__, sC, (u16*)(ws + A_Y) + (size_t)(m0 + 64) * 1024 + n0, 1024, ColId(), 64);
  }
}


#define XB_TMO      128
#define XB_XCNT(j)  (256  + 64 * (j))
#define XB_XSUB(j)  (1280 + 64 * (j))
#define XB_XGEN(j)  (2304 + 64 * (j))
#define XB_TOP      3328
#define XB_TOPGEN   3392
#define XCD_BAR_WORDS 3456
#define XB_SPIN_CAP (1u << 18)
#define LAS __attribute__((address_space(3)))
DI unsigned xb_ld(unsigned* p)              { return __hip_atomic_load(p, __ATOMIC_RELAXED, __HIP_MEMORY_SCOPE_AGENT); }
DI unsigned xb_add(unsigned* p, unsigned v) { return __hip_atomic_fetch_add(p, v, __ATOMIC_RELAXED, __HIP_MEMORY_SCOPE_AGENT); }
DI unsigned xb_xcc_id() { return (unsigned)__builtin_amdgcn_s_getreg((3 << 11) | 20) & 0xFu; }
#define XB_SPIN(cond, bar) do { unsigned _sp = 0; while (cond) { __builtin_amdgcn_s_sleep(1); \
    if ((++_sp & 255u) == 0u) { if (xb_ld(&(bar)[XB_TMO])) break; if (_sp > XB_SPIN_CAP) { atomicAdd(&(bar)[XB_TMO], 1u); break; } } } } while (0)
struct XcdBarrier { unsigned* bar; unsigned x; volatile LAS unsigned* st; };
DI XcdBarrier xcd_barrier_post(const int tid_, unsigned* bar, volatile LAS unsigned* st) {
  XcdBarrier b; b.bar = bar; b.x = xb_xcc_id(); b.st = st;
  if (tid_ == 0) (void)xb_add(&bar[XB_XCNT(b.x)], 1u);
  return b;
}
DI void xcd_barrier_complete(unsigned* bar, unsigned x, unsigned& nloc, unsigned& nx) {
  const unsigned G = gridDim.x * gridDim.y * gridDim.z;
  unsigned sum, cnt, mine, sp = 0u;
  for (;;) {
    sum = 0u; cnt = 0u; mine = 0u;
#pragma unroll
    for (unsigned j = 0; j < 16; ++j) { const unsigned c = xb_ld(&bar[XB_XCNT(j)]); sum += c; cnt += (c > 0u) ? 1u : 0u; mine = (j == x) ? c : mine; }
    if (sum == G) break;
    __builtin_amdgcn_s_sleep(1);
    if ((++sp & 255u) == 0u) { if (xb_ld(&bar[XB_TMO])) break; if (sp > XB_SPIN_CAP) { atomicAdd(&bar[XB_TMO], 1u); break; } }
  }
  nloc = mine > 0u ? mine : 1u; nx = cnt > 0u ? cnt : 1u;
}
DI void xcd_barrier(const int tid_, const XcdBarrier& b) {
  asm volatile("s_waitcnt vmcnt(0)" ::: "memory");
  __syncthreads();
  if (tid_ == 0) {
    unsigned* bar = b.bar;
    __builtin_amdgcn_s_waitcnt(0);
    unsigned nloc = b.st[0], nx = b.st[1];
    if (nloc == 0u) { xcd_barrier_complete(bar, b.x, nloc, nx); b.st[0] = nloc; b.st[1] = nx; }
    const unsigned old = xb_add(&bar[XB_XSUB(b.x)], 1u);
    const unsigned gen = old / nloc;
    if (old + 1u == (gen + 1u) * nloc) {
      __builtin_amdgcn_fence(__ATOMIC_RELEASE, "agent");
      asm volatile("s_waitcnt vmcnt(0)" ::: "memory");
      const unsigned og = xb_add(&bar[XB_TOP], 1u);
      const unsigned tg = og / nx;
      if (og + 1u == (tg + 1u) * nx) xb_add(&bar[XB_TOPGEN], 1u);
      else XB_SPIN(xb_ld(&bar[XB_TOPGEN]) == tg, bar);
      __builtin_amdgcn_fence(__ATOMIC_ACQUIRE, "agent");
      xb_add(&bar[XB_XGEN(b.x)], 1u);
      asm volatile("s_waitcnt vmcnt(0)" ::: "memory");
    } else {
      XB_SPIN(xb_ld(&bar[XB_XGEN(b.x)]) == gen, bar);
      __builtin_amdgcn_fence(__ATOMIC_ACQUIRE, "agent");
      asm volatile("s_waitcnt vmcnt(0)" ::: "memory");
    }
  }
  __syncthreads();
}

__global__ void __launch_bounds__(256, 2) mega(Params p) {
  __shared__ __attribute__((aligned(16))) unsigned char smem[SMEM_BYTES];
  __shared__ uint4 xb_words;
  const int wave_u = __builtin_amdgcn_readfirstlane((int)threadIdx.x >> 6);
  const int tid_s = (wave_u << 6) | (int)__builtin_amdgcn_mbcnt_hi(~0u, __builtin_amdgcn_mbcnt_lo(~0u, 0u));
  if (tid_s == 0) xb_words = make_uint4(0u, 0u, 0u, 0u);
  __syncthreads();
  const XcdBarrier xb = xcd_barrier_post(tid_s, (unsigned*)(p.ws + OFF_BAR), (volatile LAS unsigned*)&xb_words);
  for (int ph = p.ph_lo; ph < p.ph_hi; ++ph) {
#ifdef ONLY
    { const int l = (ph - 2) / PPL;
      if (ONLY == 0) phase0(wave_u, p, smem);
      if (ONLY == 1) phase_p1(wave_u, p, smem);
      if (ONLY == 2) phase_p2(wave_u, p, smem);
      if (ONLY == 3) phase_p3(wave_u, p, l, smem);
      if (ONLY == 4) phase_p4(wave_u, p, smem);
      if (ONLY == 5) phase_p5(wave_u, p, smem);
      if (ONLY == 6) phase_norm(wave_u, p, l, smem); }
#else
    if (ph == 0) phase0(wave_u, p, smem);
    else if (ph == 1) phase_norm(wave_u, p, -1, smem);
    else {
      const int l = (ph - 2) / PPL, sq = (ph - 2) % PPL;
      const int sp = (int)((PSEQ >> (4 * sq)) & 15);
      if (sp == 0) phase_p1(wave_u, p, smem);
      else if (sp == 1) phase_p2(wave_u, p, smem);
      else if (sp == 2) phase_p3(wave_u, p, l, smem);
      else if (sp == 3) phase_p4(wave_u, p, smem);
      else if (sp == 4) phase_p5(wave_u, p, smem);
      else phase_norm(wave_u, p, l, smem);
    }
#endif
    if (ph + 1 < p.ph_hi) {
      if (p.ph_hi > 4096) cg::this_grid().sync();
      else { FRESH_TID(tbar, wave_u); xcd_barrier(tbar, xb); }
    }
  }
}

extern "C" void kernel_launch(void* const* d_in, const int* in_sizes, int n_in, void* d_out, int out_size, void* d_ws, size_t ws_size, hipStream_t stream) {
  static int grid = 0;
  if (grid == 0) {
    if (n_in != 22 || out_size != T * D || ws_size < WS_END) {
      fprintf(stderr, "kernel_launch: unexpected sizes n_in %d out %d ws %zu (need %zu)\n", n_in, out_size, ws_size, (size_t)WS_END);
      grid = -1; return;
    }
    int dev = 0, cus = 0, per_cu = 0;
    hipGetDevice(&dev);
    hipDeviceGetAttribute(&cus, hipDeviceAttributeMultiprocessorCount, dev);
    hipOccupancyMaxActiveBlocksPerMultiprocessor(&per_cu, (const void*)mega, 256, 0);
    if (per_cu < 1) per_cu = 1;
    if (per_cu > 2) per_cu = 2;
    grid = (cus * per_cu) & ~7;
    fprintf(stderr, "kernel_launch: grid %d (%d CUs x %d)\n", grid, cus, per_cu);
  }
  if (grid < 0) return;
  Params p{};
  for (int i = 0; i < 22; ++i) p.in[i] = (const float*)d_in[i];
  p.out = (float*)d_out;
  p.ws = (unsigned char*)d_ws;
  for (int i = 0; i < 16; ++i) p.inv_freq[i] = (float)pow(10000.0, -(double)i / 16.0);
  for (int l = 0; l < 4; ++l) p.lam_init[l] = (float)(0.8 - 0.6 * exp(-0.3 * l));
#if SINGLE_LAUNCH
  if (hipMemsetAsync((char*)d_ws + OFF_BAR, 0, 24576, stream) != hipSuccess) { fprintf(stderr, "kernel_launch: memset of the barrier words failed\n"); return; }
  p.ph_lo = 0; p.ph_hi = NPHASE;
  void* args[] = {&p};
  hipError_t e = hipLaunchCooperativeKernel((const void*)mega, dim3(grid), dim3(256), args, 0, stream);
  if (e != hipSuccess) fprintf(stderr, "cooperative launch failed: %s (grid %d)\n", hipGetErrorString(e), grid);
#else
  for (int ph = 0; ph < NPHASE; ++ph) {
    p.ph_lo = ph; p.ph_hi = ph + 1;
    hipLaunchKernelGGL(mega, dim3(grid), dim3(256), 0, stream, p);
  }
#endif
}
```
